# Optimizing an MI355X kernel written in HIP

```python
import math
import jax, jax.numpy as jnp
from jax import lax
import numpy as np

D_MODEL = 4096
BATCH = 4
SEQ = 4096
DEPTH = 2

CHUNK = 64
Q_BLOCK = 128
ROPE_THETA = 500000.0
ROPE_FRACTION = 4
NORM_EPS = 1e-6

A_HEADS = 8
A_DK = 128
A_DV = 128
A_W = A_HEADS * A_DV

B_HEADS = 16
B_HD = 64
B_W = B_HEADS * B_HD
B_LORA_DECAY = 64
B_LORA_A = 64
B_LORA_G = 160
B_GN_EPS = 64e-5

C_HEADS = 16
C_KV_HEADS = 4
C_HD = 128
C_W = C_HEADS * C_HD
C_KV_W = C_KV_HEADS * C_HD
IDX_HEADS = 16
IDX_HD = 64
TOPK_MAX = 256

D_FF = 11008
CONV_W = 3

A_SIZES = (A_HEADS * A_DK, A_HEADS * A_DK, A_W, A_W)
B_SIZES = (B_W, B_W, B_W, B_LORA_DECAY, B_LORA_A, B_LORA_G)
C_SIZES = (C_W, C_KV_W, C_KV_W, IDX_HEADS * IDX_HD, IDX_HD, IDX_HEADS)
GATE_SIZES = (D_MODEL, D_MODEL, D_MODEL)
A_COLS = sum(A_SIZES)
B_COLS = sum(B_SIZES)
C_COLS = sum(C_SIZES)
IN_COLS = A_COLS + B_COLS + C_COLS + sum(GATE_SIZES)

kernel_name = 'hybrid_hgrn2_rwkv7_dsa_gated_trunk'


def split_cols(t, sizes):
    return jnp.split(t, np.cumsum(sizes)[:-1].tolist(), axis=-1)


def rms_norm(t, gain, eps=NORM_EPS):
    tf = t.astype(jnp.float32)
    y = tf * lax.rsqrt(jnp.mean(tf * tf, axis=-1, keepdims=True) + eps)
    return (y * gain.astype(jnp.float32)).astype(t.dtype)


def causal_shift(t, n):
    pad = [(0, 0)] * t.ndim
    pad[1] = (n, 0)
    return jnp.pad(t, pad)[:, :t.shape[1]]


def rope_tables(positions, head_dim):
    rot = head_dim // ROPE_FRACTION
    inv_freq = ROPE_THETA ** (-jnp.arange(0, rot, 2, dtype=jnp.float32) / rot)
    ang = positions.astype(jnp.float32)[..., None] * inv_freq
    return jnp.cos(ang), jnp.sin(ang)


def apply_partial_rope(t, cos, sin):
    half = cos.shape[-1]
    c = cos[:, :, None, :]
    s = sin[:, :, None, :]
    t1 = t[..., :half].astype(jnp.float32)
    t2 = t[..., half:2 * half].astype(jnp.float32)
    rot = jnp.concatenate([t1 * c - t2 * s, t2 * c + t1 * s], axis=-1).astype(t.dtype)
    return jnp.concatenate([rot, t[..., 2 * half:]], axis=-1)


def hgrn2_mixer(q, f_logit, i, g, lb, out_gain):
    f32 = jnp.float32
    bsz, seq, _ = q.shape
    n_chunks = seq // CHUNK
    zf = f_logit.astype(f32)
    lbf = lb.astype(f32)
    log_f = jnp.log(lbf + (1.0 - lbf) * jax.nn.sigmoid(zf))
    k_in = (1.0 - lbf) * jax.nn.sigmoid(-zf)
    qf = jax.nn.silu(q.astype(f32))

    def heads(t, d):
        return t.reshape(bsz, n_chunks, CHUNK, A_HEADS, d).transpose(1, 0, 3, 2, 4)

    causal = jnp.tril(jnp.ones((CHUNK, CHUNK), dtype=bool))

    def step(state, inp):
        qc, kc, ic, lfc = inp
        b = jnp.cumsum(lfc, axis=2)
        o_inter = jnp.einsum('bhtk,bhkv->bhtv', qc * jnp.exp(b), state)
        diff = b[:, :, :, None, :] - b[:, :, None, :, :]
        dec = jnp.exp(jnp.where(causal[:, :, None], diff, -jnp.inf))
        att = jnp.einsum('bhtk,bhsk,bhtsk->bhts', qc, kc, dec)
        o_intra = jnp.einsum('bhts,bhsv->bhtv', att, ic)
        b_last = b[:, :, -1:, :]
        state = jnp.exp(b_last[:, :, 0, :])[..., None] * state + jnp.einsum(
            'bhsk,bhsv->bhkv', kc * jnp.exp(b_last - b), ic)
        return state, o_inter + o_intra

    s0 = jnp.zeros((bsz, A_HEADS, A_DK, A_DV), f32)
    _, o = lax.scan(step, s0, (heads(qf, A_DK), heads(k_in, A_DK),
                               heads(i.astype(f32), A_DV), heads(log_f, A_DK)))
    o = o.transpose(1, 0, 3, 2, 4).reshape(bsz, seq, A_HEADS, A_DV)
    o = rms_norm(o, out_gain) * jax.nn.silu(g.astype(f32).reshape(bsz, seq, A_HEADS, A_DV))
    return o.reshape(bsz, seq, A_W).astype(q.dtype)


def rwkv7_mixer(p, mu, w0, w2, a0, a2, g2, k_k, k_a, r_k, ln_w, ln_b):
    f32 = jnp.float32
    bsz, seq, _ = p.shape
    p = p + (causal_shift(p, 1) - p) * mu
    r, k, v, wl, al, gl = split_cols(p, B_SIZES)
    w_log = -jax.nn.softplus(-(w0 + jnp.tanh(wl) @ w2).astype(f32)) - 0.5
    decay = jnp.exp(-jnp.exp(w_log))
    a = jax.nn.sigmoid((a0 + al @ a2).astype(f32))
    g = (jax.nn.sigmoid(gl) @ g2).astype(f32)

    def hv(t):
        return t.astype(f32).reshape(bsz, seq, B_HEADS, B_HD)

    r, k, v, a, decay = hv(r), hv(k), hv(v), hv(a), hv(decay)
    hn = lambda t: t.astype(f32).reshape(B_HEADS, B_HD)
    kk = k * hn(k_k)
    kk = kk / jnp.maximum(jnp.linalg.norm(kk, axis=-1, keepdims=True), 1e-12)
    k = k * (1.0 + (a - 1.0) * hn(k_a))

    def step(state, inp):
        r_t, w_t, k_t, v_t, kk_t, a_t = inp
        sa = jnp.einsum('bhvk,bhk->bhv', state, -kk_t)
        state = (state * w_t[:, :, None, :] + sa[..., None] * (kk_t * a_t)[:, :, None, :]
                 + v_t[..., None] * k_t[:, :, None, :])
        return state, jnp.einsum('bhvk,bhk->bhv', state, r_t)

    tm = lambda t: jnp.swapaxes(t, 0, 1)
    s0 = jnp.zeros((bsz, B_HEADS, B_HD, B_HD), f32)
    _, o = lax.scan(step, s0, (tm(r), tm(decay), tm(k), tm(v), tm(kk), tm(a)))
    o = tm(o)
    mean = jnp.mean(o, axis=-1, keepdims=True)
    var = jnp.mean(jnp.square(o - mean), axis=-1, keepdims=True)
    o = (o - mean) * lax.rsqrt(var + B_GN_EPS) * hn(ln_w) + hn(ln_b)
    o = o + jnp.sum(r * k * hn(r_k), axis=-1, keepdims=True) * v
    return (o.reshape(bsz, seq, B_W) * g).astype(p.dtype)


def sparse_attention_mixer(q, k, v, q_idx, k_idx, w_idx, q_gain, k_gain, cos_a, sin_a, cos_i, sin_i):
    f32 = jnp.float32
    bsz, seq, _ = q.shape
    q = apply_partial_rope(rms_norm(q.reshape(bsz, seq, C_HEADS, C_HD), q_gain), cos_a, sin_a)
    k = apply_partial_rope(rms_norm(k.reshape(bsz, seq, C_KV_HEADS, C_HD), k_gain), cos_a, sin_a)
    v = v.reshape(bsz, seq, C_KV_HEADS, C_HD)
    q_idx = apply_partial_rope(q_idx.reshape(bsz, seq, IDX_HEADS, IDX_HD), cos_i, sin_i)
    k_idx = apply_partial_rope(k_idx[:, :, None, :], cos_i, sin_i)[:, :, 0, :]
    w_idx = w_idx * (IDX_HEADS ** -0.5 * IDX_HD ** -0.5)
    topk = min(TOPK_MAX, seq // 4)
    key_chunk = jnp.arange(seq) // CHUNK
    gather = jax.vmap(lambda t, ix: t[ix])

    def block(start):
        qb = lax.dynamic_slice_in_dim(q, start, Q_BLOCK, axis=1)
        qib = lax.dynamic_slice_in_dim(q_idx, start, Q_BLOCK, axis=1)
        wb = lax.dynamic_slice_in_dim(w_idx, start, Q_BLOCK, axis=1)
        q_chunk = (start + jnp.arange(Q_BLOCK)) // CHUNK
        rel = jax.nn.relu(jnp.einsum('bqhd,bsd->bqhs', qib, k_idx).astype(f32))
        score = jnp.einsum('bqh,bqhs->bqs', wb.astype(f32), rel)
        allowed = key_chunk[None, :] <= q_chunk[:, None]
        score = jnp.where(allowed[None], score, -jnp.inf)
        vals, idx = lax.top_k(score, topk)
        valid = jnp.isfinite(vals)
        kb = gather(k, idx)
        vb = gather(v, idx)
        qg = qb.reshape(bsz, Q_BLOCK, C_KV_HEADS, C_HEADS // C_KV_HEADS, C_HD)
        logits = jnp.einsum('bqgrd,bqkgd->bqgrk', qg, kb).astype(f32) * (C_HD ** -0.5)
        logits = jnp.where(valid[:, :, None, None, :], logits, -jnp.inf)
        prob = jax.nn.softmax(logits, axis=-1).astype(vb.dtype)
        o = jnp.einsum('bqgrk,bqkgd->bqgrd', prob, vb)
        return o.reshape(bsz, Q_BLOCK, C_W)

    starts = jnp.arange(seq // Q_BLOCK) * Q_BLOCK
    o = lax.map(block, starts)
    return o.transpose(1, 0, 2, 3).reshape(bsz, seq, C_W)


def conv_ffn(h, w_up, conv_w, conv_b, w_down):
    u = h @ w_up
    u = sum(conv_w[j] * causal_shift(u, CONV_W - 1 - j) for j in range(CONV_W)) + conv_b
    gate, up = jnp.split(u, 2, axis=-1)
    return (jax.nn.silu(gate) * up) @ w_down


def setup_inputs(seed: int = 0) -> dict:
    key = jax.random.key(seed)
    ks = jax.random.split(key, 32)
    f32 = jnp.float32
    L = DEPTH

    def nrm(k, shape, scale):
        return jax.random.normal(k, shape, f32) * scale

    x = nrm(ks[0], (BATCH, SEQ, D_MODEL), 1.0)
    offsets = jax.random.randint(ks[1], (BATCH, 1), 0, 1024, dtype=jnp.int32)
    positions = (offsets + jnp.arange(SEQ, dtype=jnp.int32)[None, :]).astype(jnp.int32)
    return {
        'x': x,
        'positions': positions,
        'norm_mix': 1.0 + nrm(ks[2], (L, D_MODEL), 0.02),
        'w_in': nrm(ks[3], (L, D_MODEL, IN_COLS), D_MODEL ** -0.5),
        'hgrn_lb_logits': nrm(ks[4], (L, A_HEADS * A_DK), 0.5),
        'hgrn_out_norm': 1.0 + nrm(ks[5], (L, A_DV), 0.02),
        'rwkv_mu': jax.random.uniform(ks[6], (L, B_COLS), f32),
        'rwkv_w0': -1.0 + nrm(ks[7], (L, B_W), 0.5),
        'rwkv_w2': nrm(ks[8], (L, B_LORA_DECAY, B_W), B_LORA_DECAY ** -0.5),
        'rwkv_a0': nrm(ks[9], (L, B_W), 0.1),
        'rwkv_a2': nrm(ks[10], (L, B_LORA_A, B_W), B_LORA_A ** -0.5),
        'rwkv_g2': nrm(ks[11], (L, B_LORA_G, B_W), B_LORA_G ** -0.5),
        'rwkv_k_k': 0.85 + nrm(ks[12], (L, B_W), 0.02),
        'rwkv_k_a': 1.0 + nrm(ks[13], (L, B_W), 0.02),
        'rwkv_r_k': nrm(ks[14], (L, B_W), 0.1),
        'rwkv_ln_w': 1.0 + nrm(ks[15], (L, B_W), 0.02),
        'rwkv_ln_b': nrm(ks[16], (L, B_W), 0.02),
        'q_norm': 1.0 + nrm(ks[17], (L, C_HD), 0.02),
        'k_norm': 1.0 + nrm(ks[18], (L, C_HD), 0.02),
        'w_branch_a': nrm(ks[19], (L, A_W, D_MODEL), A_W ** -0.5),
        'w_branch_b': nrm(ks[20], (L, B_W, D_MODEL), B_W ** -0.5),
        'w_branch_c': nrm(ks[21], (L, C_W, D_MODEL), C_W ** -0.5),
        'w_out': nrm(ks[22], (L, D_MODEL, D_MODEL), D_MODEL ** -0.5),
        'norm_ffn': 1.0 + nrm(ks[23], (L, D_MODEL), 0.02),
        'w_up': nrm(ks[24], (L, D_MODEL, 2 * D_FF), D_MODEL ** -0.5),
        'conv_w': nrm(ks[25], (L, CONV_W, 2 * D_FF), CONV_W ** -0.5),
        'conv_b': nrm(ks[26], (L, 2 * D_FF), 0.02),
        'w_down': nrm(ks[27], (L, D_FF, D_MODEL), D_FF ** -0.5),
    }


def reference(x, positions, norm_mix, w_in, hgrn_lb_logits, hgrn_out_norm, rwkv_mu, rwkv_w0, rwkv_w2,
              rwkv_a0, rwkv_a2, rwkv_g2, rwkv_k_k, rwkv_k_a, rwkv_r_k, rwkv_ln_w, rwkv_ln_b,
              q_norm, k_norm, w_branch_a, w_branch_b, w_branch_c, w_out, norm_ffn, w_up, conv_w,
              conv_b, w_down):
    cos_a, sin_a = rope_tables(positions, C_HD)
    cos_i, sin_i = rope_tables(positions, IDX_HD)
    lb_all = jnp.cumsum(jax.nn.softmax(hgrn_lb_logits.astype(jnp.float32), axis=0), axis=0)
    lb_all = lb_all - lb_all[0:1]

    for l in range(DEPTH):
        h = rms_norm(x, norm_mix[l])
        p = h @ w_in[l]
        p_a, p_b, p_c, p_g = split_cols(p, (A_COLS, B_COLS, C_COLS, sum(GATE_SIZES)))

        qa, fa, ia, ga = split_cols(p_a, A_SIZES)
        o_a = hgrn2_mixer(qa, fa, ia, ga, lb_all[l], hgrn_out_norm[l])

        o_b = rwkv7_mixer(p_b, rwkv_mu[l], rwkv_w0[l], rwkv_w2[l], rwkv_a0[l], rwkv_a2[l], rwkv_g2[l],
                          rwkv_k_k[l], rwkv_k_a[l], rwkv_r_k[l], rwkv_ln_w[l], rwkv_ln_b[l])

        qc, kc, vc, qi, ki, wi = split_cols(p_c, C_SIZES)
        o_c = sparse_attention_mixer(qc, kc, vc, qi, ki, wi, q_norm[l], k_norm[l],
                                     cos_a, sin_a, cos_i, sin_i)

        gates = jax.nn.sigmoid(p_g.astype(jnp.float32)).astype(x.dtype)
        g_a, g_b, g_c = split_cols(gates, GATE_SIZES)
        merged = (g_a * (o_a @ w_branch_a[l]) + g_b * (o_b @ w_branch_b[l])
                  + g_c * (o_c @ w_branch_c[l]))
        x = x + merged @ w_out[l]

        x = x + conv_ffn(rms_norm(x, norm_ffn[l]), w_up[l], conv_w[l], conv_b[l], w_down[l])
    return x
```

```cpp
#include <hip/hip_runtime.h>
#include <cstdio>
#include <cstdint>
namespace pg8 {
#define PG8_LAS __attribute__((address_space(3)))
typedef unsigned short bf16_t;
typedef short bf16x8 __attribute__((ext_vector_type(8)));
typedef float f32x4 __attribute__((ext_vector_type(4)));
typedef unsigned u32x4 __attribute__((ext_vector_type(4)));
constexpr int BM = 256, BK = 64, HALF = 128, HTB = HALF * BK * 2  , STAGE_BYTES = 8 * HTB, NXCD = 8, WGM = 8;

__host__ __device__ __forceinline__ int lds_byte(int r, int c) { const int st = (r >> 4) * 2 + (c >> 5), rr = r & 15, cc = c & 31, ob = rr * 64 + cc * 2; return st * 1024 + (ob ^ (((ob >> 9) & 1) << 5)); }
__host__ __device__ __forceinline__ void stage_rc(int b, int& R, int& C) { const int st = b / 1024, sb = b % 1024, swz = sb ^ (((sb >> 9) & 1) << 5); R = (st >> 1) * 16 + swz / 64; C = (st & 1) * 32 + (swz % 64) / 2; }
__host__ __device__ __forceinline__ int perm32(int rho) { const int n = rho >> 4, i = rho & 15; return 8 * (i >> 2) + 4 * n + (i & 3); }

struct Unit { int pm, pn; };
struct Gemm { const bf16_t* A; const bf16_t* Bt; int M, N, K; };

struct StaticOrder {
    int nM, nN, nwg, G, c;
    __host__ __device__ void init(int M, int N, int G_, int c_) { nM = M / BM; nN = N / BM; nwg = nM * nN; G = G_; c = c_; }
    __host__ __device__ bool next(int i, Unit& u) const {
        const long L = (long)i * G + c; if (L >= nwg) return false;
        int wgid = (int)L; { const int q = nwg / NXCD, r = nwg % NXCD, xcd = wgid % NXCD, off = wgid / NXCD; wgid = (xcd < r ? xcd * (q + 1) : r * (q + 1) + (xcd - r) * q) + off; }
        const int nig = WGM * nN, gid = wgid / nig, fm = gid * WGM, gsz = (nM - fm) < WGM ? (nM - fm) : WGM;
        u.pm = fm + ((wgid % nig) % gsz); u.pn = (wgid % nig) / gsz; return true;
    }
    __device__ __forceinline__ void a_ready(const Unit&) const {}
    __device__ __forceinline__ void done(const Unit&) const {}
};

typedef __bf16 bf16x2_t __attribute__((ext_vector_type(2)));
__device__ __forceinline__ unsigned cvt_pk_bf16(float lo, float hi) { bf16x2_t v; v.x = (__bf16)lo; v.y = (__bf16)hi; return __builtin_bit_cast(unsigned, v); }
typedef unsigned u32x2 __attribute__((ext_vector_type(2)));
__device__ __forceinline__ float fsigmoid(float x) { return __builtin_amdgcn_rcpf(1.0f + __expf(-x)); }

struct EpiP1 {
    static constexpr bool PERM = false, AFTER_DRAIN = false;
    float* PA; float* PB; float* PC; const float* rs;
    __device__ __forceinline__ void operator()(const f32x4 (&acc)[2][2][4][2], const Unit& u, int wr, int wc, int fr, int fq) const {
        float* base; int ld, colt;
        if (u.pn < 16) { base = PA; ld = 4096; colt = u.pn * BM; } else if (u.pn < 30) { base = PB; ld = 3584; colt = (u.pn - 16) * BM; } else { base = PC; ld = 4352; colt = (u.pn - 30) * BM; }
        const int row0 = u.pm * BM + wr * 64 + fr, col0 = colt + wc * 32 + 4 * fq;
#pragma unroll
        for (int ai = 0; ai < 2; ++ai)
#pragma unroll
            for (int m = 0; m < 4; ++m) { const int row = row0 + ai * HALF + m * 16; const float s = rs[row]; float* rowp = base + (size_t)row * ld + col0;
#pragma unroll
                for (int bj = 0; bj < 2; ++bj)
#pragma unroll
                    for (int n = 0; n < 2; ++n) *(f32x4*)(rowp + bj * HALF + n * 16) = acc[ai][bj][m][n] * s; }
    }
};
template <int ACT> struct EpiB16 {
    static constexpr bool PERM = true, AFTER_DRAIN = false;
    bf16_t* O; int ldc; const float* rs;
    __device__ __forceinline__ void operator()(const f32x4 (&acc)[2][2][4][2], const Unit& u, int wr, int wc, int fr, int fq) const {
        const int row0 = u.pm * BM + wr * 64 + fr, col0 = u.pn * BM + wc * 32 + 8 * fq;
#pragma unroll
        for (int ai = 0; ai < 2; ++ai)
#pragma unroll
            for (int m = 0; m < 4; ++m) { const int row = row0 + ai * HALF + m * 16; const float s = rs[row]; bf16_t* rowp = O + (size_t)row * ldc + col0;
#pragma unroll
                for (int bj = 0; bj < 2; ++bj) { f32x4 v0 = acc[ai][bj][m][0] * s, v1 = acc[ai][bj][m][1] * s;
                    if (ACT == 1) {
#pragma unroll
                        for (int j = 0; j < 4; ++j) { v0[j] = fsigmoid(v0[j]); v1[j] = fsigmoid(v1[j]); } }
                    u32x4 w; w.x = cvt_pk_bf16(v0[0], v0[1]); w.y = cvt_pk_bf16(v0[2], v0[3]); w.z = cvt_pk_bf16(v1[0], v1[1]); w.w = cvt_pk_bf16(v1[2], v1[3]);
                    *(u32x4*)(rowp + bj * HALF) = w; } }
    }
};
struct EpiF32 {
    static constexpr bool PERM = false, AFTER_DRAIN = false;
    float* C; int ldc;
    __device__ __forceinline__ void operator()(const f32x4 (&acc)[2][2][4][2], const Unit& u, int wr, int wc, int fr, int fq) const {
        const int row0 = u.pm * BM + wr * 64 + fr, col0 = u.pn * BM + wc * 32 + 4 * fq;
#pragma unroll
        for (int ai = 0; ai < 2; ++ai)
#pragma unroll
            for (int m = 0; m < 4; ++m) { float* rowp = C + (size_t)(row0 + ai * HALF + m * 16) * ldc + col0;
#pragma unroll
                for (int bj = 0; bj < 2; ++bj)
#pragma unroll
                    for (int n = 0; n < 2; ++n) *(f32x4*)(rowp + bj * HALF + n * 16) = acc[ai][bj][m][n]; }
    }
};
template <int MODE> struct EpiMerge {
    static constexpr bool PERM = false, AFTER_DRAIN = false;
    float* MG; bf16_t* OUT; const bf16_t* G; int goff;
    __device__ __forceinline__ void operator()(const f32x4 (&acc)[2][2][4][2], const Unit& u, int wr, int wc, int fr, int fq) const {
        const int row0 = u.pm * BM + wr * 64 + fr, col0 = u.pn * BM + wc * 32 + 4 * fq;
#pragma unroll
        for (int ai = 0; ai < 2; ++ai)
#pragma unroll
            for (int m = 0; m < 4; ++m) { const size_t row = (size_t)(row0 + ai * HALF + m * 16);
#pragma unroll
                for (int bj = 0; bj < 2; ++bj)
#pragma unroll
                    for (int n = 0; n < 2; ++n) { const int col = col0 + bj * HALF + n * 16;
                        const u32x2 gw = *(const u32x2*)(G + row * 12288 + goff + col);
                        f32x4 g; g[0] = __uint_as_float(gw.x << 16); g[1] = __uint_as_float(gw.x & 0xffff0000u); g[2] = __uint_as_float(gw.y << 16); g[3] = __uint_as_float(gw.y & 0xffff0000u);
                        f32x4 v = acc[ai][bj][m][n] * g;
                        float* mp = MG + row * 4096 + col;
                        if (MODE >= 1) v = v + *(const f32x4*)mp;
                        if (MODE <= 1) *(f32x4*)mp = v;
                        else { u32x2 w; w.x = cvt_pk_bf16(v[0], v[1]); w.y = cvt_pk_bf16(v[2], v[3]); *(u32x2*)(OUT + row * 4096 + col) = w; } } }
    }
};
struct EpiRes {
    static constexpr bool PERM = false, AFTER_DRAIN = false;
    const float* base; float* out; int ldc;
    __device__ __forceinline__ void operator()(const f32x4 (&acc)[2][2][4][2], const Unit& u, int wr, int wc, int fr, int fq) const {
        const int row0 = u.pm * BM + wr * 64 + fr, col0 = u.pn * BM + wc * 32 + 4 * fq;
#pragma unroll
        for (int ai = 0; ai < 2; ++ai)
#pragma unroll
            for (int m = 0; m < 4; ++m) { const size_t off = (size_t)(row0 + ai * HALF + m * 16) * ldc + col0;
#pragma unroll
                for (int bj = 0; bj < 2; ++bj)
#pragma unroll
                    for (int n = 0; n < 2; ++n) { const f32x4 bs = *(const f32x4*)(base + off + bj * HALF + n * 16); *(f32x4*)(out + off + bj * HALF + n * 16) = bs + acc[ai][bj][m][n]; } }
    }
};
template <class Epi, class Sched, bool ALIGN_EPI = false, bool SP2 = false>
__device__ __forceinline__ void gemm_phase(PG8_LAS unsigned char* lds, const Gemm g, const Sched& S, const Epi& E, const int wave_id) {
    int lane__; asm volatile("v_mbcnt_lo_u32_b32 %0, -1, 0\n\tv_mbcnt_hi_u32_b32 %0, -1, %0" : "=v"(lane__)); const int tid_ = wave_id * 64 + lane__;
    const int tid = tid_, wid = __builtin_amdgcn_readfirstlane(tid >> 6), lane = tid & 63, wr = wid >> 2, wc = wid & 3, fr = lane & 15, fq = lane >> 4;
    int K_ = g.K; asm volatile("" : "+s"(K_));
    const int K = K_, nt = K / BK;
    unsigned voffA[2], voffB[2];
#pragma unroll
    for (int i = 0; i < 2; ++i) { int R, C; stage_rc(tid * 16 + i * 8192, R, C); const int Rb = Epi::PERM ? ((R & ~31) + perm32(R & 31)) : R;
        voffA[i] = (unsigned)(R * K + C) * 2u; voffB[i] = (unsigned)(Rb * K + C) * 2u; }
    const size_t kstep = (size_t)(BK * 2);
    const size_t hstep = (size_t)HALF * K * 2;
    const size_t tstep = 2 * hstep;
    const unsigned ldsw = (unsigned)wid * 1024u;
    const int aoff = lds_byte(wr * 64 + fr, fq * 8), boff = lds_byte(wc * 32 + fr, fq * 8);
#define PG8_SA(b, h) (((b) * 2 + (h)) * HTB)
#define PG8_SB(b, h) ((4 + (b) * 2 + (h)) * HTB)
#define PG8_STAGE(bufoff, gbase, voff) do { _Pragma("unroll") for (int _i = 0; _i < 2; ++_i) \
        __builtin_amdgcn_global_load_lds((const unsigned*)((const char*)(gbase) + (voff)[_i]), (PG8_LAS unsigned*)(lds + (bufoff) + ldsw + _i * 8192), 16, 0, 0); } while (0)
#define PG8_LDA(dst, b, h) do { _Pragma("unroll") for (int m = 0; m < 4; ++m) _Pragma("unroll") for (int k = 0; k < 2; ++k) dst[m][k] = *(const PG8_LAS bf16x8*)(lds + PG8_SA(b, h) + aoff + m * 2048 + k * 1024); } while (0)
#define PG8_LDB(dst, b, h) do { _Pragma("unroll") for (int n = 0; n < 2; ++n) _Pragma("unroll") for (int k = 0; k < 2; ++k) dst[n][k] = *(const PG8_LAS bf16x8*)(lds + PG8_SB(b, h) + boff + n * 2048 + k * 1024); } while (0)
#define PG8_MMA(ai, bj, At, Bt) do { __builtin_amdgcn_s_setprio(1); _Pragma("unroll") for (int m = 0; m < 4; ++m) _Pragma("unroll") for (int n = 0; n < 2; ++n) _Pragma("unroll") for (int k = 0; k < 2; ++k) \
        acc[ai][bj][m][n] = __builtin_amdgcn_mfma_f32_16x16x32_bf16(Bt[n][k], At[m][k], acc[ai][bj][m][n], 0, 0, 0); __builtin_amdgcn_s_setprio(0); } while (0)
#define PG8_WAIT_V(n) asm volatile("s_waitcnt vmcnt(" #n ")" ::: "memory")
#define PG8_WAIT_L(n) asm volatile("s_waitcnt lgkmcnt(" #n ")" ::: "memory")
#define PG8_BAR __builtin_amdgcn_s_barrier()
#define PG8_SCHED __builtin_amdgcn_sched_barrier(0)
    Unit cur, nxt; int ui = 0;
    if (!S.next(0, cur)) return;
    f32x4 acc[2][2][4][2];
#pragma unroll
    for (int a = 0; a < 2; ++a)
#pragma unroll
        for (int b = 0; b < 2; ++b)
#pragma unroll
            for (int m = 0; m < 4; ++m)
#pragma unroll
                for (int n = 0; n < 2; ++n) acc[a][b][m][n] = (f32x4){0.f, 0.f, 0.f, 0.f};
    bf16x8 At[4][2], B0[2][2], B1[2][2];
    const char* cA = (const char*)g.A + (size_t)cur.pm * tstep; const char* cB = (const char*)g.Bt + (size_t)cur.pn * tstep;
    S.a_ready(cur);
    if constexpr (SP2) {
        PG8_STAGE(PG8_SB(0, 0), cB, voffB); PG8_STAGE(PG8_SB(0, 1), cB + hstep, voffB); PG8_STAGE(PG8_SA(0, 0), cA, voffA); PG8_STAGE(PG8_SA(0, 1), cA + hstep, voffA);
        if (wr == 1) PG8_BAR;
        PG8_WAIT_V(2); PG8_BAR;
        PG8_STAGE(PG8_SB(1, 0), cB + kstep, voffB); PG8_STAGE(PG8_SA(1, 0), cA + kstep, voffA); PG8_STAGE(PG8_SB(1, 1), cB + hstep + kstep, voffB);
        PG8_WAIT_V(6); PG8_BAR;
    } else {
        PG8_STAGE(PG8_SB(0, 0), cB, voffB); PG8_STAGE(PG8_SA(0, 0), cA, voffA); PG8_STAGE(PG8_SB(0, 1), cB + hstep, voffB); PG8_STAGE(PG8_SA(0, 1), cA + hstep, voffA);
        if (wr == 1) PG8_BAR;
        PG8_WAIT_V(4); PG8_BAR;
        PG8_STAGE(PG8_SB(1, 0), cB + kstep, voffB); PG8_STAGE(PG8_SA(1, 0), cA + kstep, voffA); PG8_STAGE(PG8_SB(1, 1), cB + hstep + kstep, voffB);
        PG8_WAIT_V(6); PG8_BAR;
    }
    for (;;) {
        const bool has_next = S.next(ui + 1, nxt);
        const char* nA = has_next ? (const char*)g.A + (size_t)nxt.pm * tstep : cA; const char* nB = has_next ? (const char*)g.Bt + (size_t)nxt.pn * tstep : cB;
        for (int t = 0; t < nt; t += 2) {
            const bool last = (t == nt - 2);
            const char* a1 = cA + (size_t)(t + 1) * kstep;
            const char* a2 = last ? nA : cA + (size_t)(t + 2) * kstep; const char* b2 = last ? nB : cB + (size_t)(t + 2) * kstep;
            const char* a3 = a2 + kstep; const char* b3 = b2 + kstep;
            if (last && has_next) S.a_ready(nxt);
            if constexpr (SP2) {
            PG8_LDB(B0, 0, 0); PG8_LDB(B1, 0, 1); PG8_SCHED; PG8_LDA(At, 0, 0); PG8_STAGE(PG8_SA(1, 1), a1 + hstep, voffA);
            PG8_WAIT_V(8); PG8_WAIT_L(0); PG8_BAR; PG8_MMA(0, 0, At, B0); PG8_MMA(0, 1, At, B1); PG8_BAR; PG8_SCHED;
            PG8_LDA(At, 0, 1); PG8_STAGE(PG8_SB(0, 0), b2, voffB); PG8_STAGE(PG8_SB(0, 1), b2 + hstep, voffB); PG8_STAGE(PG8_SA(0, 0), a2, voffA);
            PG8_WAIT_V(8); PG8_WAIT_L(0); PG8_BAR; PG8_MMA(1, 0, At, B0); PG8_MMA(1, 1, At, B1); PG8_BAR; PG8_SCHED;
            PG8_LDB(B0, 1, 0); PG8_LDB(B1, 1, 1); PG8_SCHED; PG8_LDA(At, 1, 0); PG8_STAGE(PG8_SA(0, 1), a2 + hstep, voffA);
            PG8_WAIT_V(8); PG8_WAIT_L(0); PG8_BAR; PG8_MMA(0, 0, At, B0); PG8_MMA(0, 1, At, B1); PG8_BAR; PG8_SCHED;
            PG8_LDA(At, 1, 1); PG8_STAGE(PG8_SB(1, 0), b3, voffB); PG8_STAGE(PG8_SB(1, 1), b3 + hstep, voffB); PG8_STAGE(PG8_SA(1, 0), a3, voffA);
            PG8_WAIT_V(8); PG8_WAIT_L(0); PG8_BAR; PG8_MMA(1, 0, At, B0); PG8_MMA(1, 1, At, B1); PG8_BAR; PG8_SCHED;
            } else {
            PG8_LDB(B0, 0, 0); PG8_SCHED; PG8_LDA(At, 0, 0); PG8_STAGE(PG8_SA(1, 1), a1 + hstep, voffA);
            PG8_WAIT_L(8); PG8_BAR; PG8_WAIT_L(0); PG8_MMA(0, 0, At, B0); PG8_BAR; PG8_SCHED;
            PG8_LDB(B1, 0, 1); PG8_STAGE(PG8_SB(0, 0), b2, voffB);
            PG8_BAR; PG8_WAIT_L(0); PG8_MMA(0, 1, At, B1); PG8_BAR;
            PG8_LDA(At, 0, 1); PG8_STAGE(PG8_SA(0, 0), a2, voffA);
            PG8_BAR; PG8_WAIT_L(0); PG8_MMA(1, 0, At, B0); PG8_BAR; PG8_SCHED;
            PG8_STAGE(PG8_SB(0, 1), b2 + hstep, voffB);
            PG8_WAIT_V(6); PG8_BAR; PG8_MMA(1, 1, At, B1); PG8_BAR;
            PG8_LDB(B0, 1, 0); PG8_SCHED; PG8_LDA(At, 1, 0); PG8_STAGE(PG8_SA(0, 1), a2 + hstep, voffA);
            PG8_WAIT_L(8); PG8_BAR; PG8_WAIT_L(0); PG8_MMA(0, 0, At, B0); PG8_BAR; PG8_SCHED;
            PG8_LDB(B1, 1, 1); PG8_STAGE(PG8_SB(1, 0), b3, voffB);
            PG8_BAR; PG8_WAIT_L(0); PG8_MMA(0, 1, At, B1); PG8_BAR;
            PG8_LDA(At, 1, 1); PG8_STAGE(PG8_SA(1, 0), a3, voffA);
            PG8_BAR; PG8_WAIT_L(0); PG8_MMA(1, 0, At, B0); PG8_BAR; PG8_SCHED;
            PG8_STAGE(PG8_SB(1, 1), b3 + hstep, voffB);
            PG8_WAIT_V(6); PG8_BAR; PG8_MMA(1, 1, At, B1); PG8_BAR;
            }
        }
        if constexpr (ALIGN_EPI) { if (wr == 0) PG8_BAR; }
        if constexpr (!Epi::AFTER_DRAIN) { E(acc, cur, wr, wc, fr, fq); S.done(cur); }
        if (!has_next) break;
#pragma unroll
        for (int a = 0; a < 2; ++a)
#pragma unroll
            for (int b = 0; b < 2; ++b)
#pragma unroll
                for (int m = 0; m < 4; ++m)
#pragma unroll
                    for (int n = 0; n < 2; ++n) acc[a][b][m][n] = (f32x4){0.f, 0.f, 0.f, 0.f};
        cur = nxt; cA = nA; cB = nB; ++ui;
        if constexpr (ALIGN_EPI) { if (wr == 1) PG8_BAR; }
    }
    PG8_WAIT_V(0);
    if constexpr (!ALIGN_EPI) { if (wr == 0) PG8_BAR; }
    PG8_BAR;
    if constexpr (Epi::AFTER_DRAIN) { E.fused(acc, cur, wr, wc, fr, fq, lds, wid, lane); S.done(cur); }
#undef PG8_SA
#undef PG8_SB
#undef PG8_STAGE
#undef PG8_LDA
#undef PG8_LDB
#undef PG8_MMA
#undef PG8_WAIT_V
#undef PG8_WAIT_L
#undef PG8_BAR
#undef PG8_SCHED
}
}
constexpr int NB = 4, SEQ = 4096, DM = 4096, M = NB * SEQ;
constexpr int DFF = 11008, NUP = 2 * DFF;
constexpr int IN_COLS = 23920;
constexpr int NA1 = 12032, NGT = 12288, NWIN = NA1 + NGT;
constexpr int LDPA = 4096, LDPB = 3584, LDPC = 4352;
constexpr int NLORA = 3072, KLORA = 384;
constexpr float NORM_EPS = 1e-6f;
constexpr int NWAVES = 8;
constexpr size_t MiB = 1u << 20;
constexpr size_t WS_CTL = 0, CTL_ZERO_BYTES = 1 * MiB;
constexpr size_t WS_WIN = 1 * MiB;
constexpr size_t WS_WA = WS_WIN + (size_t)NWIN * DM * 2;
constexpr size_t WS_WB = WS_WA + (size_t)DM * 1024 * 2;
constexpr size_t WS_WC = WS_WB + (size_t)DM * 1024 * 2;
constexpr size_t WS_WOUT = WS_WC + (size_t)DM * 2048 * 2;
constexpr size_t WS_WUP = WS_WOUT + (size_t)DM * DM * 2;
constexpr size_t WS_WDN = WS_WUP + (size_t)NUP * DM * 2;
constexpr size_t WS_WLORA = WS_WDN + (size_t)DM * DFF * 2;
constexpr size_t WS_XB = WS_WLORA + (size_t)NLORA * KLORA * 2;
constexpr size_t WS_RS = WS_XB + (size_t)M * DM * 2;
constexpr size_t WS_ROPE = WS_RS + (size_t)M * 4;
constexpr size_t WS_R1 = WS_ROPE + (size_t)M * 48 * 4;
constexpr size_t WS_G = WS_R1;
constexpr size_t WS_PA = WS_G + (size_t)M * NGT * 2;
constexpr size_t WS_PB = WS_PA + (size_t)M * LDPA * 4;
constexpr size_t WS_PC = WS_PB + (size_t)M * LDPB * 4;
constexpr size_t WS_R1_END = WS_PC + (size_t)M * LDPC * 4;
constexpr size_t WS_SCANIN = WS_PB;
constexpr size_t WS_MG = WS_PB;
constexpr size_t WS_MERGED = WS_MG + (size_t)M * DM * 4;
constexpr size_t WS_U = WS_R1;
constexpr size_t WS_ACT = WS_U + (size_t)M * NUP * 2;
static_assert(WS_SCANIN + (size_t)64 * 4096 * 320 * 4 <= WS_R1_END && WS_MERGED + (size_t)M * DM * 2 <= WS_R1_END && WS_ACT + (size_t)M * DFF * 2 <= WS_R1_END, "R1 overlays");
constexpr size_t WS_LA = WS_R1_END;
constexpr size_t WS_LO = WS_LA + (size_t)M * KLORA * 2;
constexpr size_t WS_RKV = WS_LO + (size_t)M * NLORA * 4;
constexpr size_t WS_SC = WS_RKV + (size_t)M * 3072 * 4;
constexpr size_t WS_MASK = WS_SC + (size_t)NB * SEQ * SEQ * 4;
constexpr size_t WS_QC = WS_MASK + (size_t)M * 64 * 8;
constexpr size_t WS_KC = WS_QC + (size_t)M * 2048 * 2;
constexpr size_t WS_VT = WS_KC + (size_t)M * 512 * 2;
constexpr size_t WS_QI = WS_VT + (size_t)M * 512 * 2;
constexpr size_t WS_KI = WS_QI + (size_t)M * 1024 * 2;
constexpr size_t WS_WI = WS_KI + (size_t)M * 64 * 2;
constexpr size_t WS_RK = WS_WI + (size_t)M * 16 * 4;
constexpr size_t WS_OAR = WS_RK + (size_t)M * 16 * 4;
constexpr size_t WS_OBR = WS_OAR + (size_t)M * 1024 * 4;
constexpr size_t WS_OA = WS_OBR + (size_t)M * 1024 * 4;
constexpr size_t WS_OB = WS_OA + (size_t)M * 1024 * 2;
constexpr size_t WS_OC = WS_OB + (size_t)M * 1024 * 2;
constexpr size_t WS_END = WS_OC + (size_t)M * 2048 * 2;
static_assert(WS_END <= (size_t)3135242240ull, "workspace map exceeds 4x the largest input");
constexpr int CW_TMO = 0, CW_CODE = 1, CW_BAR = 4096;
constexpr int RING_OFF = 0, RING_BYTES = 131072;
constexpr int LDSCTL_OFF = RING_BYTES, MISC_OFF = LDSCTL_OFF + 320;
constexpr int LDS_BYTES = 147456;
#define GAS __attribute__((address_space(1)))
#define LAS __attribute__((address_space(3)))
typedef unsigned short bf16;
typedef unsigned v4u __attribute__((ext_vector_type(4)));
typedef float f32x4 __attribute__((ext_vector_type(4)));
typedef short bf16x8 __attribute__((ext_vector_type(8)));
typedef GAS unsigned gu32;
typedef GAS unsigned long long gu64;
#define RLX_AGENT __ATOMIC_RELAXED, __HIP_MEMORY_SCOPE_AGENT
#define LDS_WAIT() asm volatile("s_waitcnt lgkmcnt(0)" ::: "memory")
#define VM_WAIT() asm volatile("s_waitcnt vmcnt(0)" ::: "memory")
__device__ __forceinline__ unsigned long long rt() { return __builtin_amdgcn_s_memrealtime(); }
__device__ __forceinline__ unsigned f2bf(float f) { unsigned u = __builtin_bit_cast(unsigned, f); return (u + 0x7fffu + ((u >> 16) & 1u)) >> 16; }
__device__ __forceinline__ unsigned pk2(float lo, float hi) { return f2bf(lo) | (f2bf(hi) << 16); }

#define XB_TMO      128
#define XB_XCNT(j)  (256  + 64 * (j))
#define XB_XSUB(j)  (1280 + 64 * (j))
#define XB_XGEN(j)  (2304 + 64 * (j))
#define XB_TOP      3328
#define XB_TOPGEN   3392
#define XCD_BAR_WORDS 3456
#define XB_SPIN_CAP (1u << 18)

__device__ __forceinline__ unsigned xb_ld(unsigned* p)              { return __hip_atomic_load(p, __ATOMIC_RELAXED, __HIP_MEMORY_SCOPE_AGENT); }
__device__ __forceinline__ unsigned xb_add(unsigned* p, unsigned v) { return __hip_atomic_fetch_add(p, v, __ATOMIC_RELAXED, __HIP_MEMORY_SCOPE_AGENT); }
__device__ __forceinline__ unsigned xb_xcc_id() { return (unsigned)__builtin_amdgcn_s_getreg((3 << 11) | 20) & 0xFu; }
#define XB_SPIN(cond, bar) do { unsigned _sp = 0; while (cond) { __builtin_amdgcn_s_sleep(1); \
    if ((++_sp & 255u) == 0u) { if (xb_ld(&(bar)[XB_TMO])) break; if (_sp > XB_SPIN_CAP) { atomicAdd(&(bar)[XB_TMO], 1u); break; } } } } while (0)

struct XcdBarrier {
    unsigned* bar; unsigned x;
    volatile LAS unsigned* st;
};

__device__ __forceinline__ XcdBarrier xcd_barrier_post(unsigned* bar, volatile LAS unsigned* st) {
    XcdBarrier b; b.bar = bar; b.x = xb_xcc_id(); b.st = st;
    if (threadIdx.x == 0) (void)xb_add(&bar[XB_XCNT(b.x)], 1u);
    return b;
}
__device__ __forceinline__ void xcd_barrier_complete(unsigned* bar, unsigned x, unsigned& nloc, unsigned& nx) {
    const unsigned G = gridDim.x * gridDim.y * gridDim.z;
    unsigned sum, cnt, mine, sp = 0u;
    for (;;) {
        sum = 0u; cnt = 0u; mine = 0u;
#pragma unroll
        for (unsigned j = 0; j < 16; ++j) { const unsigned c = xb_ld(&bar[XB_XCNT(j)]); sum += c; cnt += (c > 0u) ? 1u : 0u; mine = (j == x) ? c : mine; }
        if (sum == G) break;
        __builtin_amdgcn_s_sleep(1);
        if ((++sp & 255u) == 0u) { if (xb_ld(&bar[XB_TMO])) break; if (sp > XB_SPIN_CAP) { atomicAdd(&bar[XB_TMO], 1u); break; } }
    }
    nloc = mine > 0u ? mine : 1u; nx = cnt > 0u ? cnt : 1u;
}

__device__ __forceinline__ void xcd_barrier(const XcdBarrier& b) {
    asm volatile("s_waitcnt vmcnt(0)" ::: "memory");
    __syncthreads();
    if (threadIdx.x == 0) {
        unsigned* bar = b.bar;
        __builtin_amdgcn_s_waitcnt(0);
        unsigned nloc = b.st[0], nx = b.st[1];
        if (nloc == 0u) { xcd_barrier_complete(bar, b.x, nloc, nx); b.st[0] = nloc; b.st[1] = nx; }
        const unsigned old = xb_add(&bar[XB_XSUB(b.x)], 1u);
        const unsigned gen = old / nloc;
        if (old + 1u == (gen + 1u) * nloc) {
            __builtin_amdgcn_fence(__ATOMIC_RELEASE, "agent");
            asm volatile("s_waitcnt vmcnt(0)" ::: "memory");
            const unsigned og = xb_add(&bar[XB_TOP], 1u);
            const unsigned tg = og / nx;
            if (og + 1u == (tg + 1u) * nx) xb_add(&bar[XB_TOPGEN], 1u);
            else XB_SPIN(xb_ld(&bar[XB_TOPGEN]) == tg, bar);
            __builtin_amdgcn_fence(__ATOMIC_ACQUIRE, "agent");
            xb_add(&bar[XB_XGEN(b.x)], 1u);
            asm volatile("s_waitcnt vmcnt(0)" ::: "memory");
        } else {
            XB_SPIN(xb_ld(&bar[XB_XGEN(b.x)]) == gen, bar);
            __builtin_amdgcn_fence(__ATOMIC_ACQUIRE, "agent");
            asm volatile("s_waitcnt vmcnt(0)" ::: "memory");
        }
    }
    __syncthreads();
}

typedef unsigned u32x2v __attribute__((ext_vector_type(2)));
typedef unsigned long long u64;
struct Frame {
    LAS unsigned char* lds;
    volatile LAS unsigned* MISC;
    gu32* ctl;
    int tid, lane, wave, G;
    unsigned char* ws;
    const void* const* in;
};
#define OPAQUE_IDS() int wave_ = F.wave; asm volatile("" : "+s"(wave_)); const int wave = wave_; int lane_; asm volatile("v_mbcnt_lo_u32_b32 %0, -1, 0\n\tv_mbcnt_hi_u32_b32 %0, -1, %0" : "=v"(lane_)); const int lane = lane_; const int tid = wave * 64 + lane; (void)lane; (void)wave; (void)tid; unsigned char* wsb = F.ws; asm volatile("" : "+s"(wsb)); int bid_ = blockIdx.x; asm volatile("" : "+s"(bid_)); const int bid = bid_; int G_ = F.G; asm volatile("" : "+s"(G_)); const int G = G_; (void)bid; (void)G
__device__ __forceinline__ float wave_sum(float v) {
#pragma unroll
    for (int o = 1; o < 64; o <<= 1) v += __shfl_xor(v, o);
    return v;
}
__device__ __forceinline__ float bf2f(unsigned short h) { return __uint_as_float(((unsigned)h) << 16); }
__device__ __forceinline__ unsigned pkbf(float lo, float hi) { return pg8::cvt_pk_bf16(lo, hi); }
__device__ __forceinline__ float fsig(float x) { return 1.0f / (1.0f + __expf(-x)); }
template <int CTRL> __device__ __forceinline__ float dppf(float v) { return __builtin_bit_cast(float, __builtin_amdgcn_update_dpp(0, __builtin_bit_cast(int, v), CTRL, 0xf, 0xf, false)); }
__device__ __forceinline__ float sum16(float v) { v += dppf<0xB1>(v); v += dppf<0x4E>(v); v += dppf<0x124>(v); v += dppf<0x128>(v); return v; }

template <int MAP> __device__ __forceinline__ int wcol_map(int n) {
    if (MAP == 0) return n;
    if (n < 7456) return n; if (n < 7680) return -1; if (n < 11856) return n - 224; if (n < 12032) return -1; return n - 400;
}
template <int MAP> __device__ __forceinline__ void conv_item(const float* W, int K, int ldw, const float* gain, bf16* WT, LAS float* scr, int item, int nblk, int lane) {
    const int kb = item / nblk, nb = item % nblk, k0 = 64 * kb, n0 = 32 * nb;
    const int src = wcol_map<MAP>(n0 + (lane & 31));
#pragma unroll 8
    for (int i = 0; i < 32; ++i) { const int kk = 2 * i + (lane >> 5); float v = 0.f;
        if (src >= 0) { v = W[(size_t)(k0 + kk) * ldw + src]; if (gain) v *= gain[k0 + kk]; }
        scr[kk * 33 + (lane & 31)] = v; }
    LDS_WAIT(); asm volatile("" ::: "memory");
    const int c = lane & 7;
#pragma unroll
    for (int j = 0; j < 4; ++j) { const int n = (lane >> 3) + 8 * j; const LAS float* s = scr + (8 * c) * 33 + n;
        v4u o; o.x = pkbf(s[0 * 33], s[1 * 33]); o.y = pkbf(s[2 * 33], s[3 * 33]); o.z = pkbf(s[4 * 33], s[5 * 33]); o.w = pkbf(s[6 * 33], s[7 * 33]);
        *(GAS v4u*)(WT + (size_t)(n0 + n) * K + k0 + 8 * c) = o; }
    LDS_WAIT(); asm volatile("" ::: "memory");
}
struct LayerIn {
    const float *norm_mix, *w_in, *lb0, *lb1, *out_norm, *mu, *w0, *w2, *a0, *a2, *g2, *k_k, *k_a, *r_k, *ln_w, *ln_b, *q_norm, *k_norm, *wba, *wbb, *wbc, *w_out, *norm_ffn, *w_up, *conv_w, *conv_b, *w_down;
};
__device__ __forceinline__ void phase_weights(Frame& F, const LayerIn& L) {
    OPAQUE_IDS();
    LAS float* scr = (LAS float*)(F.lds + RING_OFF + wave * 16384);
    const int gw = bid * NWAVES + wave, NGW = G * NWAVES;
    constexpr int I_IN = (DM / 64) * (NWIN / 32), I_A = (1024 / 64) * (DM / 32), I_C = (2048 / 64) * (DM / 32), I_O = (DM / 64) * (DM / 32), I_UP = (DM / 64) * (NUP / 32), I_DN = (DFF / 64) * (DM / 32);
    constexpr int NITEMS = I_IN + 2 * I_A + I_C + I_O + I_UP + I_DN;
    bf16* ws = (bf16*)wsb;
    for (int it = gw; it < NITEMS; it += NGW) {
        int r = it;
        if (r < I_IN) { conv_item<1>(L.w_in, DM, IN_COLS, L.norm_mix, (bf16*)(wsb + WS_WIN), scr, r, NWIN / 32, lane); continue; } r -= I_IN;
        if (r < I_A) { conv_item<0>(L.wba, 1024, DM, nullptr, (bf16*)(wsb + WS_WA), scr, r, DM / 32, lane); continue; } r -= I_A;
        if (r < I_A) { conv_item<0>(L.wbb, 1024, DM, nullptr, (bf16*)(wsb + WS_WB), scr, r, DM / 32, lane); continue; } r -= I_A;
        if (r < I_C) { conv_item<0>(L.wbc, 2048, DM, nullptr, (bf16*)(wsb + WS_WC), scr, r, DM / 32, lane); continue; } r -= I_C;
        if (r < I_O) { conv_item<0>(L.w_out, DM, DM, nullptr, (bf16*)(wsb + WS_WOUT), scr, r, DM / 32, lane); continue; } r -= I_O;
        if (r < I_UP) { conv_item<0>(L.w_up, DM, NUP, L.norm_ffn, (bf16*)(wsb + WS_WUP), scr, r, NUP / 32, lane); continue; } r -= I_UP;
        conv_item<0>(L.w_down, DFF, DM, nullptr, (bf16*)(wsb + WS_WDN), scr, r, DM / 32, lane);
    }
    (void)ws;
    bf16* WL = (bf16*)(wsb + WS_WLORA);
    for (int e = bid * 512 + tid; e < NLORA * KLORA; e += G * 512) {
        const int n = e / KLORA, k = e % KLORA, seg = n >> 10, col = n & 1023; float v = 0.f;
        if (seg == 0) { if (k < 64) v = L.w2[(size_t)k * 1024 + col]; }
        else if (seg == 1) { if (k >= 64 && k < 128) v = L.a2[(size_t)(k - 64) * 1024 + col]; }
        else { if (k >= 128 && k < 288) v = L.g2[(size_t)(k - 128) * 1024 + col]; }
        WL[e] = (bf16)(pkbf(v, 0.f) & 0xffffu);
    }
}
__device__ __forceinline__ void phase_norm(Frame& F, const float* x) {
    OPAQUE_IDS();
    const int gw = bid * NWAVES + wave, NGW = G * NWAVES;
    bf16* XB = (bf16*)(wsb + WS_XB); float* RS = (float*)(wsb + WS_RS);
    for (int m = gw; m < M; m += NGW) {
        const GAS f32x4* xr = (const GAS f32x4*)(x + (size_t)m * DM) + lane;
        GAS u64* o8 = (GAS u64*)(XB + (size_t)m * DM) + lane;
        float s = 0.f;
#pragma unroll
        for (int j = 0; j < 16; ++j) { const f32x4 v = xr[64 * j]; s += (v.x * v.x + v.y * v.y) + (v.z * v.z + v.w * v.w);
            o8[64 * j] = (u64)pkbf(v.x, v.y) | ((u64)pkbf(v.z, v.w) << 32); }
        s = wave_sum(s);
        if (lane == 0) RS[m] = 1.0f / sqrtf(s * (1.0f / DM) + NORM_EPS);
    }
}
__device__ __forceinline__ void sincos_acc(float angf, float& sn, float& cs) {
    const double x = (double)angf;
    const double q = rint(x * 0.63661977236758134308);
    const double y = (x - q * 1.57079632679489655800) - q * 6.123233995736766036e-17;
    const double y2 = y * y;
    const double sp = y * (1.0 + y2 * (-1.0 / 6 + y2 * (1.0 / 120 + y2 * (-1.0 / 5040 + y2 * (1.0 / 362880 + y2 * (-1.0 / 39916800 + y2 * (1.0 / 6227020800.0)))))));
    const double cp = 1.0 + y2 * (-0.5 + y2 * (1.0 / 24 + y2 * (-1.0 / 720 + y2 * (1.0 / 40320 + y2 * (-1.0 / 3628800 + y2 * (1.0 / 479001600 + y2 * (-1.0 / 87178291200.0)))))));
    const int qi = ((int)(long long)q) & 3;
    double s, c;
    if (qi == 0) { s = sp; c = cp; } else if (qi == 1) { s = cp; c = -sp; } else if (qi == 2) { s = -sp; c = -cp; } else { s = -cp; c = sp; }
    sn = (float)s; cs = (float)c;
}
__device__ __forceinline__ float rope_invf(int i) {
    switch (i) {
    case 0: return 1.000000000e+00f; case 1: return 4.403665960e-01f; case 2: return 1.939227432e-01f; case 3: return 8.539710194e-02f;
    case 4: return 3.760603070e-02f; case 5: return 1.656044088e-02f; case 6: return 7.292664610e-03f; case 7: return 3.211446106e-03f;
    case 8: return 1.414213562e-03f; case 9: return 6.227724371e-04f; case 10: return 2.742481884e-04f; case 11: return 1.207697351e-04f;
    case 12: return 5.318295734e-05f; case 13: return 2.341999971e-05f; case 14: return 1.031338525e-05f; case 15: return 4.541670478e-06f;
    case 16: return 1.000000000e+00f; case 17: return 1.939227432e-01f; case 18: return 3.760603070e-02f; case 19: return 7.292664610e-03f;
    case 20: return 1.414213562e-03f; case 21: return 2.742481884e-04f; case 22: return 5.318295734e-05f; default: return 1.031338525e-05f; }
}
__device__ __forceinline__ void phase_rope_tables(Frame& F, const int* positions) {
    OPAQUE_IDS();
    float* RT = (float*)(wsb + WS_ROPE);
    for (int e = bid * 512 + tid; e < M * 24; e += G * 512) {
        const int m = e / 24, i = e % 24; const float pos = (float)positions[m];
        const float ang = pos * rope_invf(i); float sn, cs; sincos_acc(ang, sn, cs);
        if (i < 16) { RT[(size_t)m * 48 + i] = cs; RT[(size_t)m * 48 + 16 + i] = sn; } else { RT[(size_t)m * 48 + 32 + (i - 16)] = cs; RT[(size_t)m * 48 + 40 + (i - 16)] = sn; }
    }
}
__device__ __forceinline__ void phase_prep(Frame& F, const LayerIn& L) {
    OPAQUE_IDS();
    const int gw = bid * NWAVES + wave, NGW = G * NWAVES;
    const float* PB = (const float*)(wsb + WS_PB); float* RKV = (float*)(wsb + WS_RKV); bf16* LA = (bf16*)(wsb + WS_LA);
    for (int m = gw; m < M; m += NGW) {
        const bool has_prev = (m % SEQ) != 0;
        const float* cur = PB + (size_t)m * LDPB; const float* prv = cur - LDPB;
        for (int c4 = lane; c4 < 840; c4 += 64) {
            const int c = c4 * 4;
            const f32x4 pc = *(const GAS f32x4*)(cur + c); f32x4 pp = (f32x4){0.f, 0.f, 0.f, 0.f}; if (has_prev) pp = *(const GAS f32x4*)(prv + c);
            const f32x4 mu = *(const GAS f32x4*)(L.mu + c);
            const f32x4 ps = pc + (pp - pc) * mu;
            if (c < 3072) { *(GAS f32x4*)(RKV + (size_t)m * 3072 + c) = ps; }
            else { f32x4 o = ps;
                if (c < 3136) { o.x = tanhf(ps.x); o.y = tanhf(ps.y); o.z = tanhf(ps.z); o.w = tanhf(ps.w); }
                else if (c >= 3200) { o.x = fsig(ps.x); o.y = fsig(ps.y); o.z = fsig(ps.z); o.w = fsig(ps.w); }
                *(GAS u64*)(LA + (size_t)m * KLORA + (c - 3072)) = (u64)pkbf(o.x, o.y) | ((u64)pkbf(o.z, o.w) << 32); }
        }
        if (lane < 24) { u64 z = 0ull; asm volatile("" : "+v"(z)); *(GAS u64*)(LA + (size_t)m * KLORA + 288 + lane * 4) = z; }
    }
    const float* PC = (const float*)(wsb + WS_PC); const float* RT = (const float*)(wsb + WS_ROPE);
    bf16* QC = (bf16*)(wsb + WS_QC); bf16* KC = (bf16*)(wsb + WS_KC); bf16* VT = (bf16*)(wsb + WS_VT); bf16* QI = (bf16*)(wsb + WS_QI); bf16* KI = (bf16*)(wsb + WS_KI); float* WI = (float*)(wsb + WS_WI);
    LAS bf16* VL = (LAS bf16*)(F.lds + RING_OFF);
    constexpr float QSCALE = 0.08838834764831845f * 1.4426950408889634f;
    for (int blk = bid; blk < M / 64; blk += G) {
        __syncthreads();
        for (int tt = 0; tt < 8; ++tt) {
            const int tl = wave * 8 + tt, m = blk * 64 + tl;
            const float* prow = PC + (size_t)m * LDPC; const float* rt = RT + (size_t)m * 48;
#pragma unroll
            for (int pass = 0; pass < 2; ++pass) {
                const bool act = (pass == 0) || (lane < 16);
                const float* src = prow + (pass == 0 ? 0 : 2048) + lane * 32; const float* gain = (pass == 0 ? L.q_norm : L.k_norm) + (lane & 3) * 32;
                float y[32]; float ss = 0.f;
#pragma unroll
                for (int i = 0; i < 8; ++i) { f32x4 v = (f32x4){0.f, 0.f, 0.f, 0.f}; if (act) v = *(const GAS f32x4*)(src + 4 * i); y[4 * i] = v.x; y[4 * i + 1] = v.y; y[4 * i + 2] = v.z; y[4 * i + 3] = v.w; ss += (v.x * v.x + v.y * v.y) + (v.z * v.z + v.w * v.w); }
                ss += __shfl_xor(ss, 1); ss += __shfl_xor(ss, 2);
                const float rinv = 1.0f / sqrtf(ss * (1.0f / 128.0f) + NORM_EPS);
#pragma unroll
                for (int i = 0; i < 32; ++i) y[i] = y[i] * rinv * gain[i];
                if ((lane & 3) == 0) {
#pragma unroll
                    for (int i = 0; i < 16; ++i) { const float cs = rt[i], sn = rt[16 + i], a = y[i], b2 = y[i + 16]; y[i] = a * cs - b2 * sn; y[i + 16] = b2 * cs + a * sn; } }
                const float sc = (pass == 0) ? QSCALE : 1.0f;
                if (act) { bf16* dst = (pass == 0 ? QC + (size_t)m * 2048 : KC + (size_t)m * 512) + lane * 32;
#pragma unroll
                    for (int i = 0; i < 4; ++i) { v4u o; o.x = pkbf(y[8 * i] * sc, y[8 * i + 1] * sc); o.y = pkbf(y[8 * i + 2] * sc, y[8 * i + 3] * sc); o.z = pkbf(y[8 * i + 4] * sc, y[8 * i + 5] * sc); o.w = pkbf(y[8 * i + 6] * sc, y[8 * i + 7] * sc);
                        *(GAS v4u*)(dst + 8 * i) = o; } }
            }
#pragma unroll
            for (int pass = 0; pass < 2; ++pass) {
                const bool act = (pass == 0) || (lane < 4);
                const float* src = prow + (pass == 0 ? 3072 : 4096) + lane * 16;
                float y[16];
#pragma unroll
                for (int i = 0; i < 4; ++i) { f32x4 v = (f32x4){0.f, 0.f, 0.f, 0.f}; if (act) v = *(const GAS f32x4*)(src + 4 * i); y[4 * i] = v.x; y[4 * i + 1] = v.y; y[4 * i + 2] = v.z; y[4 * i + 3] = v.w; }
                if ((lane & 3) == 0) {
#pragma unroll
                    for (int i = 0; i < 8; ++i) { const float cs = rt[32 + i], sn = rt[40 + i], a = y[i], b2 = y[i + 8]; y[i] = a * cs - b2 * sn; y[i + 8] = b2 * cs + a * sn; } }
                if (act) { bf16* dst = (pass == 0 ? QI + (size_t)m * 1024 : KI + (size_t)m * 64) + lane * 16;
#pragma unroll
                    for (int i = 0; i < 2; ++i) { v4u o; o.x = pkbf(y[8 * i], y[8 * i + 1]); o.y = pkbf(y[8 * i + 2], y[8 * i + 3]); o.z = pkbf(y[8 * i + 4], y[8 * i + 5]); o.w = pkbf(y[8 * i + 6], y[8 * i + 7]);
                        *(GAS v4u*)(dst + 8 * i) = o; } }
            }
            if (lane < 16) WI[(size_t)m * 16 + lane] = prow[4160 + lane] * 0.03125f;
            { const f32x4 v0 = *(const GAS f32x4*)(prow + 2560 + lane * 8), v1 = *(const GAS f32x4*)(prow + 2560 + lane * 8 + 4);
              const unsigned p0 = pkbf(v0.x, v0.y), p1 = pkbf(v0.z, v0.w), p2 = pkbf(v1.x, v1.y), p3 = pkbf(v1.z, v1.w);
              LAS bf16* d = VL + (lane * 8) * 72 + tl;
              d[0] = (bf16)(p0 & 0xffffu); d[72] = (bf16)(p0 >> 16); d[144] = (bf16)(p1 & 0xffffu); d[216] = (bf16)(p1 >> 16);
              d[288] = (bf16)(p2 & 0xffffu); d[360] = (bf16)(p2 >> 16); d[432] = (bf16)(p3 & 0xffffu); d[504] = (bf16)(p3 >> 16); }
        }
        __syncthreads();
        { const int d = tid, g = d >> 7, dd = d & 127, b = blk / 64, t0 = (blk % 64) * 64;
          bf16* dst = VT + ((size_t)((b * 4 + g) * 128 + dd)) * SEQ + t0; const LAS bf16* s = VL + d * 72;
#pragma unroll
          for (int i = 0; i < 8; ++i) *(GAS v4u*)(dst + 8 * i) = *(const LAS v4u*)(s + 8 * i); }
    }
    __syncthreads();
}
__device__ __forceinline__ void phase_indexer(Frame& F) {
    OPAQUE_IDS();
    const int fr = lane & 15, fq = lane >> 4;
    const bf16* QI = (const bf16*)(wsb + WS_QI); const bf16* KI = (const bf16*)(wsb + WS_KI); const float* WI = (const float*)(wsb + WS_WI); float* SC = (float*)(wsb + WS_SC);
    for (int gw = bid * NWAVES + wave; gw < SEQ / 2; gw += G * NWAVES) {
        for (int it = 0; it < 8; ++it) {
            const int b = it >> 1, t = (it & 1) ? (SEQ - 1 - gw) : gw, m = b * SEQ + t;
            const bf16x8 a0 = *(const GAS bf16x8*)(QI + (size_t)m * 1024 + fr * 64 + fq * 8), a1 = *(const GAS bf16x8*)(QI + (size_t)m * 1024 + fr * 64 + 32 + fq * 8);
            const f32x4 w4 = *(const GAS f32x4*)(WI + (size_t)m * 16 + fq * 4);
            const int ntile = (t >> 6) + 1;
            float* srow = SC + (size_t)m * SEQ; const bf16* kbase = KI + (size_t)b * SEQ * 64;
            for (int kt = 0; kt < ntile; ++kt) {
                float keep = 0.f;
#pragma unroll
                for (int i = 0; i < 4; ++i) {
                    const bf16* kr = kbase + (size_t)(kt * 64 + i * 16 + fr) * 64 + fq * 8;
                    const bf16x8 b0 = *(const GAS bf16x8*)kr, b1 = *(const GAS bf16x8*)(kr + 32);
                    f32x4 acc = (f32x4){0.f, 0.f, 0.f, 0.f};
                    acc = __builtin_amdgcn_mfma_f32_16x16x32_bf16(a0, b0, acc, 0, 0, 0);
                    acc = __builtin_amdgcn_mfma_f32_16x16x32_bf16(a1, b1, acc, 0, 0, 0);
                    float v = w4.x * fmaxf(acc[0], 0.f) + w4.y * fmaxf(acc[1], 0.f) + w4.z * fmaxf(acc[2], 0.f) + w4.w * fmaxf(acc[3], 0.f);
                    v += __shfl_xor(v, 16); v += __shfl_xor(v, 32);
                    if (fq == i) keep = v;
                }
                srow[kt * 64 + lane] = keep;
            }
        }
    }
}
__device__ __forceinline__ void phase_bprep2(Frame& F, const LayerIn& L) {
    OPAQUE_IDS();
    const int gw = bid * NWAVES + wave, NGW = G * NWAVES;
    const float* RKV = (const float*)(wsb + WS_RKV); const float* LO = (const float*)(wsb + WS_LO); float* SI = (float*)(wsb + WS_SCANIN); float* RK = (float*)(wsb + WS_RK);
    for (int m = gw; m < M; m += NGW) {
        const int c0 = lane * 16, head = lane >> 2, b = m / SEQ, t = m % SEQ;
        float kk[16], wv[16], kka[16], kp[16], rr[16]; float ss = 0.f, rk = 0.f;
#pragma unroll
        for (int i4 = 0; i4 < 4; ++i4) {
            const int c = c0 + 4 * i4;
            const f32x4 r = *(const GAS f32x4*)(RKV + (size_t)m * 3072 + c), k = *(const GAS f32x4*)(RKV + (size_t)m * 3072 + 1024 + c);
            const f32x4 dw = *(const GAS f32x4*)(LO + (size_t)m * 3072 + c), da = *(const GAS f32x4*)(LO + (size_t)m * 3072 + 1024 + c);
            const f32x4 w0 = *(const GAS f32x4*)(L.w0 + c), a0 = *(const GAS f32x4*)(L.a0 + c), k_k = *(const GAS f32x4*)(L.k_k + c), k_a = *(const GAS f32x4*)(L.k_a + c), r_k = *(const GAS f32x4*)(L.r_k + c);
#pragma unroll
            for (int j = 0; j < 4; ++j) {
                const int i = 4 * i4 + j;
                const float x = w0[j] + dw[j];
                const float y = -x; const float sp = fmaxf(y, 0.f) + log1pf(__expf(-fabsf(y)));
                const float wlog = -sp - 0.5f;
                wv[i] = __expf(-__expf(wlog));
                const float a = fsig(a0[j] + da[j]);
                const float kkv = k[j] * k_k[j]; kk[i] = kkv; ss += kkv * kkv;
                const float kpv = k[j] * (1.0f + (a - 1.0f) * k_a[j]); kp[i] = kpv;
                kka[i] = a;
                rr[i] = r[j]; rk += r[j] * kpv * r_k[j];
            }
        }
        ss += __shfl_xor(ss, 1); ss += __shfl_xor(ss, 2); rk += __shfl_xor(rk, 1); rk += __shfl_xor(rk, 2);
        const float inv = 1.0f / fmaxf(sqrtf(ss), 1e-12f);
#pragma unroll
        for (int i = 0; i < 16; ++i) { kk[i] *= inv; kka[i] *= kk[i]; }
        float* dst = SI + ((size_t)(b * 16 + head) * SEQ + t) * 320 + (lane & 3) * 16;
#pragma unroll
        for (int i4 = 0; i4 < 4; ++i4) {
            *(GAS f32x4*)(dst + 0 * 64 + 4 * i4) = (f32x4){kk[4 * i4], kk[4 * i4 + 1], kk[4 * i4 + 2], kk[4 * i4 + 3]};
            *(GAS f32x4*)(dst + 1 * 64 + 4 * i4) = (f32x4){wv[4 * i4], wv[4 * i4 + 1], wv[4 * i4 + 2], wv[4 * i4 + 3]};
            *(GAS f32x4*)(dst + 2 * 64 + 4 * i4) = (f32x4){kka[4 * i4], kka[4 * i4 + 1], kka[4 * i4 + 2], kka[4 * i4 + 3]};
            *(GAS f32x4*)(dst + 3 * 64 + 4 * i4) = (f32x4){kp[4 * i4], kp[4 * i4 + 1], kp[4 * i4 + 2], kp[4 * i4 + 3]};
            *(GAS f32x4*)(dst + 4 * 64 + 4 * i4) = (f32x4){rr[4 * i4], rr[4 * i4 + 1], rr[4 * i4 + 2], rr[4 * i4 + 3]};
        }
        if ((lane & 3) == 0) RK[(size_t)m * 16 + head] = rk;
    }
}
__device__ __forceinline__ unsigned f2key(float f) { const unsigned u = __float_as_uint(f); return (u & 0x80000000u) ? ~u : (u | 0x80000000u); }
__device__ __forceinline__ void phase_select(Frame& F) {
    OPAQUE_IDS();
    const float* SC = (const float*)(wsb + WS_SC); u64* MK = (u64*)(wsb + WS_MASK);
    for (int gw = bid * NWAVES + wave; gw < SEQ / 2; gw += G * NWAVES) {
        for (int it = 0; it < 8; ++it) {
            const int b = it >> 1, t = (it & 1) ? (SEQ - 1 - gw) : gw, m = b * SEQ + t, qc = t >> 6;
            u64* mout = MK + (size_t)m * 64;
            if (qc < 4) { mout[lane] = (lane <= qc) ? ~0ull : 0ull; continue; }
            const float* srow = SC + (size_t)m * SEQ;
            unsigned key[64];
#pragma unroll
            for (int j = 0; j < 64; ++j) { key[j] = 0u; if (j <= qc) key[j] = f2key(srow[j * 64 + lane]); }
            unsigned prefix = 0u;
            for (int bit = 31; bit >= 0; --bit) {
                const unsigned cand = prefix | (1u << bit); int cnt = 0;
#pragma unroll
                for (int j = 0; j < 64; ++j) cnt += (key[j] >= cand) ? 1 : 0;
#pragma unroll
                for (int o = 1; o < 64; o <<= 1) cnt += __shfl_xor(cnt, o);
                if (cnt >= 256) prefix = cand;
            }
            u64 mine = 0ull;
#pragma unroll
            for (int j = 0; j < 64; ++j) { const u64 mk = __ballot(key[j] >= prefix); if (lane == j) mine = mk; __builtin_amdgcn_sched_barrier(0); }
            mout[lane] = mine;
        }
    }
}
__device__ __forceinline__ void phase_scan(Frame& F) {
    OPAQUE_IDS();
    const float* SI = (const float*)(wsb + WS_SCANIN); const float* RKV = (const float*)(wsb + WS_RKV); float* OBR = (float*)(wsb + WS_OBR);
    LAS float* stg = (LAS float*)(F.lds + RING_OFF);
    LAS float* vst = stg + 2 * 10240;
    LAS float* ost = vst + 2 * 512;
    for (int item = bid; item < 256; item += G) {
        const int bh = item >> 2, qr = item & 3, b = bh >> 4, h = bh & 15;
        const float* src = SI + (size_t)bh * SEQ * 320;
        const float* vsrc = RKV + (size_t)(b * SEQ) * 3072 + 2048 + h * 64 + qr * 16;
        float* odst = OBR + (size_t)(b * SEQ) * 1024 + h * 64 + qr * 16;
        __syncthreads();
        f32x4 ld[5]; float lv;
#pragma unroll
        for (int i = 0; i < 5; ++i) ld[i] = *(const GAS f32x4*)(src + (size_t)(tid + 512 * i) * 4);
        lv = vsrc[(size_t)(tid >> 4) * 3072 + (tid & 15)];
#pragma unroll
        for (int i = 0; i < 5; ++i) *(LAS f32x4*)(stg + (tid + 512 * i) * 4) = ld[i];
        vst[tid] = lv;
        __syncthreads();
        float S0 = 0.f, S1 = 0.f, S2 = 0.f, S3 = 0.f;
        const int row = wave * 4 + (lane >> 4), kq = (lane & 15) * 4;
        for (int blk = 0; blk < SEQ / 32; ++blk) {
            const int cb = blk & 1, nb = cb ^ 1;
            if (blk + 1 < SEQ / 32) {
#pragma unroll
                for (int i = 0; i < 5; ++i) ld[i] = *(const GAS f32x4*)(src + (size_t)(blk + 1) * 10240 + (size_t)(tid + 512 * i) * 4);
                lv = vsrc[(size_t)((blk + 1) * 32 + (tid >> 4)) * 3072 + (tid & 15)];
            }
            if (blk > 0) odst[(size_t)((blk - 1) * 32 + (tid >> 4)) * 1024 + (tid & 15)] = ost[nb * 512 + tid];
            if (wave < 4) {
                const LAS float* sb = stg + cb * 10240 + kq; const LAS float* vb = vst + cb * 512 + row; LAS float* ob = ost + cb * 512 + row;
#pragma unroll 4
                for (int s = 0; s < 32; ++s) {
                    const f32x4 kk = *(const LAS f32x4*)(sb + s * 320), w = *(const LAS f32x4*)(sb + s * 320 + 64), ka = *(const LAS f32x4*)(sb + s * 320 + 128), kp = *(const LAS f32x4*)(sb + s * 320 + 192), r = *(const LAS f32x4*)(sb + s * 320 + 256);
                    const float v = vb[s * 16];
                    float sa = (S0 * kk.x + S1 * kk.y) + (S2 * kk.z + S3 * kk.w);
                    sa = -sum16(sa);
                    S0 = S0 * w.x + (sa * ka.x + v * kp.x); S1 = S1 * w.y + (sa * ka.y + v * kp.y); S2 = S2 * w.z + (sa * ka.z + v * kp.z); S3 = S3 * w.w + (sa * ka.w + v * kp.w);
                    float o = (S0 * r.x + S1 * r.y) + (S2 * r.z + S3 * r.w);
                    o = sum16(o);
                    if ((lane & 15) == 0) ob[s * 16] = o;
                }
            }
            if (blk + 1 < SEQ / 32) {
#pragma unroll
                for (int i = 0; i < 5; ++i) *(LAS f32x4*)(stg + nb * 10240 + (tid + 512 * i) * 4) = ld[i];
                vst[nb * 512 + tid] = lv;
            }
            __syncthreads();
        }
        odst[(size_t)((SEQ / 32 - 1) * 32 + (tid >> 4)) * 1024 + (tid & 15)] = ost[((SEQ / 32 - 1) & 1) * 512 + tid];
    }
    __syncthreads();
}
__device__ __forceinline__ bf16x8 pack8(const float (&v)[8]) {
    v4u o; o.x = pkbf(v[0], v[1]); o.y = pkbf(v[2], v[3]); o.z = pkbf(v[4], v[5]); o.w = pkbf(v[6], v[7]); return __builtin_bit_cast(bf16x8, o);
}
__device__ __forceinline__ void phase_hgrn(Frame& F, const LayerIn& L, int layer) {
    OPAQUE_IDS();
    const int fr = lane & 15, fq = lane >> 4;
    const float* PA = (const float*)(wsb + WS_PA); float* OAR = (float*)(wsb + WS_OAR);
    LAS float* CL = (LAS float*)(F.lds + 0);
    LAS float* KIN = (LAS float*)(F.lds + 33792);
    LAS bf16* QT = (LAS bf16*)(F.lds + 67584);
    LAS bf16* IT = (LAS bf16*)(F.lds + 84992);
    LAS bf16* ST = (LAS bf16*)(F.lds + 87296);
    LAS float* TOT = (LAS float*)(F.lds + 104704);
    LAS float* RR = (LAS float*)(F.lds + 106752);
    for (int item = bid; item < 256; item += G) {
        const int b = item >> 6, h = (item >> 3) & 7, js = item & 7;
        const int k = tid & 127, I = tid >> 7;
        float lb = 0.f;
        if (layer == 1) lb = fsig(L.lb1[h * 128 + k] - L.lb0[h * 128 + k]);
        const float omlb = 1.0f - lb;
        f32x4 st = (f32x4){0.f, 0.f, 0.f, 0.f};
        for (int c = 0; c < SEQ / 64; ++c) {
            const int m0 = b * SEQ + c * 64;
            __syncthreads();
            { float cl = 0.f;
#pragma unroll 4
              for (int tt = 0; tt < 16; ++tt) {
                  const int t = 16 * I + tt; const float* prow = PA + (size_t)(m0 + t) * LDPA + h * 128 + k;
                  const float qv = prow[0], z = prow[1024];
                  const float sig = 1.0f / (1.0f + __expf(-z));
                  const float f = lb + omlb * sig;
                  cl += __logf(f);
                  const float kin = omlb / (1.0f + __expf(z));
                  const float qf = qv / (1.0f + __expf(-qv));
                  CL[t * 132 + k] = cl; KIN[t * 132 + k] = kin;
                  QT[t * 136 + k] = (bf16)(pkbf(qf * __expf(cl), 0.f) & 0xffffu);
              }
              TOT[I * 128 + k] = cl; }
#pragma unroll
            for (int r = 0; r < 2; ++r) { const int e = tid + 512 * r, t = e >> 4, v = e & 15;
                IT[v * 72 + t] = (bf16)(pkbf(PA[(size_t)(m0 + t) * LDPA + 2048 + h * 128 + js * 16 + v], 0.f) & 0xffffu); }
            __syncthreads();
            if (tid < 128) { const float t0 = TOT[tid], t1 = TOT[128 + tid], t2 = TOT[256 + tid], t3 = TOT[384 + tid];
                RR[tid] = 0.f; RR[128 + tid] = t0; RR[256 + tid] = t0 + t1; RR[384 + tid] = (t0 + t1) + t2; RR[512 + tid] = ((t0 + t1) + t2) + t3; }
            __syncthreads();
            { const int kk = 16 * wave + fr;
#pragma unroll
              for (int Ib = 0; Ib < 4; ++Ib) { const float e = __expf(RR[Ib * 128 + kk]);
#pragma unroll
                  for (int j = 0; j < 4; ++j) ST[(Ib * 16 + 4 * fq + j) * 136 + kk] = (bf16)(pkbf(st[j] * e, 0.f) & 0xffffu); } }
            __syncthreads();
            if (wave < 4) {
                const int Iw = wave;
                bf16x8 qb[4];
#pragma unroll
                for (int ks = 0; ks < 4; ++ks) qb[ks] = *(const LAS bf16x8*)(QT + (16 * Iw + fr) * 136 + 32 * ks + 8 * fq);
                f32x4 at[4];
#pragma unroll
                for (int J = 0; J < 4; ++J) { at[J] = (f32x4){0.f, 0.f, 0.f, 0.f};
                    if (J <= Iw) {
#pragma unroll
                        for (int ks = 0; ks < 4; ++ks) {
                            const int s = 16 * J + fr, k0 = 32 * ks + 8 * fq; float a[8];
#pragma unroll
                            for (int hh = 0; hh < 2; ++hh) {
                                const f32x4 kin4 = *(const LAS f32x4*)(KIN + s * 132 + k0 + 4 * hh), cl4 = *(const LAS f32x4*)(CL + s * 132 + k0 + 4 * hh);
                                const f32x4 ri = *(const LAS f32x4*)(RR + Iw * 128 + k0 + 4 * hh), rj = *(const LAS f32x4*)(RR + J * 128 + k0 + 4 * hh);
#pragma unroll
                                for (int j = 0; j < 4; ++j) a[4 * hh + j] = kin4[j] * __expf(fminf(ri[j] - rj[j] - cl4[j], 80.f));
                            }
                            at[J] = __builtin_amdgcn_mfma_f32_16x16x32_bf16(pack8(a), qb[ks], at[J], 0, 0, 0);
                        }
                        if (J == Iw) {
#pragma unroll
                            for (int j = 0; j < 4; ++j) if (4 * fq + j > fr) at[J][j] = 0.f; }
                    } }
                f32x4 oacc = (f32x4){0.f, 0.f, 0.f, 0.f};
#pragma unroll
                for (int ks = 0; ks < 4; ++ks) { const bf16x8 sa = *(const LAS bf16x8*)(ST + (Iw * 16 + fr) * 136 + 32 * ks + 8 * fq);
                    oacc = __builtin_amdgcn_mfma_f32_16x16x32_bf16(sa, qb[ks], oacc, 0, 0, 0); }
#pragma unroll
                for (int p = 0; p < 2; ++p) if (2 * p <= Iw) {
                    float pv[8];
#pragma unroll
                    for (int j = 0; j < 4; ++j) { pv[j] = at[2 * p][j]; pv[4 + j] = at[2 * p + 1][j]; }
                    const u32x2v i0 = *(const LAS u32x2v*)(IT + fr * 72 + 32 * p + 4 * fq), i1 = *(const LAS u32x2v*)(IT + fr * 72 + 32 * p + 16 + 4 * fq);
                    v4u ia; ia.x = i0.x; ia.y = i0.y; ia.z = i1.x; ia.w = i1.y;
                    oacc = __builtin_amdgcn_mfma_f32_16x16x32_bf16(__builtin_bit_cast(bf16x8, ia), pack8(pv), oacc, 0, 0, 0);
                }
                *(GAS f32x4*)(OAR + (size_t)(m0 + 16 * Iw + fr) * 1024 + h * 128 + js * 16 + 4 * fq) = oacc;
            }
            { const int kk = 16 * wave + fr; const float r4 = RR[512 + kk]; const float e4 = __expf(r4);
              st = st * e4;
#pragma unroll
              for (int ks = 0; ks < 2; ++ks) {
                  const bf16x8 ia = *(const LAS bf16x8*)(IT + fr * 72 + 32 * ks + 8 * fq);
                  const int J = 2 * ks + (fq >> 1); const float rj = RR[J * 128 + kk]; float kb[8];
#pragma unroll
                  for (int j = 0; j < 8; ++j) { const int s = 32 * ks + 8 * fq + j; kb[j] = KIN[s * 132 + kk] * __expf(fminf(r4 - rj - CL[s * 132 + kk], 80.f)); }
                  st = __builtin_amdgcn_mfma_f32_16x16x32_bf16(ia, pack8(kb), st, 0, 0, 0);
              } }
        }
    }
    __syncthreads();
}
__device__ __forceinline__ void phase_attn(Frame& F) {
    OPAQUE_IDS();
    const int fr = lane & 15, fq = lane >> 4;
    const bf16* QC = (const bf16*)(wsb + WS_QC); const bf16* KC = (const bf16*)(wsb + WS_KC); const bf16* VT = (const bf16*)(wsb + WS_VT); const u64* MK = (const u64*)(wsb + WS_MASK);
    bf16* OC = (bf16*)(wsb + WS_OC);
    LAS bf16* KS = (LAS bf16*)(F.lds + 0);
    LAS bf16* VS = (LAS bf16*)(F.lds + 2 * 17408);
    const float NEG_INF = -__builtin_inff();
    for (int wgi = bid; wgi < 256; wgi += G) {
        const int combo = wgi >> 4, r16 = wgi & 15, b = combo >> 2, g = combo & 3;
        for (int ui = 0; ui < 4; ++ui) {
            const int qc = (ui == 0) ? r16 : (ui == 1) ? 31 - r16 : (ui == 2) ? 32 + r16 : 63 - r16;
            const int hq = g * 4 + (wave >> 1), tq0 = qc * 64 + (wave & 1) * 32;
            bf16x8 Qf[2][4];
#pragma unroll
            for (int qb = 0; qb < 2; ++qb)
#pragma unroll
                for (int ks = 0; ks < 4; ++ks) Qf[qb][ks] = *(const GAS bf16x8*)(QC + (size_t)(b * SEQ + tq0 + qb * 16 + fr) * 2048 + hq * 128 + 32 * ks + 8 * fq);
            f32x4 O[8][2];
#pragma unroll
            for (int db = 0; db < 8; ++db) { O[db][0] = (f32x4){0.f, 0.f, 0.f, 0.f}; O[db][1] = (f32x4){0.f, 0.f, 0.f, 0.f}; }
            float mrow[2] = {NEG_INF, NEG_INF}, lrow[2] = {0.f, 0.f};
            v4u sreg[2];
            const char* kg = (const char*)(KC + (size_t)(b * SEQ) * 512 + g * 128); const char* vg = (const char*)(VT + (size_t)((b * 4 + g) * 128) * SEQ);
            unsigned kgo[2], vgo[2], klo[2], vlo[2];
#pragma unroll
            for (int i = 0; i < 2; ++i) { const int c = tid + 512 * i; kgo[i] = (unsigned)(((c >> 4) * 512 + (c & 15) * 8) * 2); vgo[i] = (unsigned)(((c >> 3) * SEQ + (c & 7) * 8) * 2);
                klo[i] = (unsigned)(((c >> 4) * 136 + (c & 15) * 8) * 2); vlo[i] = (unsigned)(2 * 17408 + ((c >> 3) * 72 + (c & 7) * 8) * 2); }
            __syncthreads();
#pragma unroll
            for (int i = 0; i < 2; ++i) sreg[i] = *(const GAS v4u*)(kg + kgo[i]);
#pragma unroll
            for (int i = 0; i < 2; ++i) *(LAS v4u*)(F.lds + klo[i]) = sreg[i];
#pragma unroll
            for (int i = 0; i < 2; ++i) sreg[i] = *(const GAS v4u*)(vg + vgo[i]);
#pragma unroll
            for (int i = 0; i < 2; ++i) *(LAS v4u*)(F.lds + vlo[i]) = sreg[i];
            __syncthreads();
            const u64* mkb = MK + (size_t)(b * SEQ) * 64; const unsigned mko0 = (unsigned)((tq0 + fr) * 64), mko1 = mko0 + 16 * 64;
            for (int kt = 0; kt <= qc; ++kt) {
                const int cb = kt & 1, nb = cb ^ 1;
                const bool more = kt < qc;
                if (more) {
#pragma unroll
                    for (int i = 0; i < 2; ++i) sreg[i] = *(const GAS v4u*)(kg + (size_t)(kt + 1) * (64 * 512 * 2) + kgo[i]);
                }
                u64 mw[2];
                mw[0] = mkb[mko0 + kt] >> (4 * fq); mw[1] = mkb[mko1 + kt] >> (4 * fq);
                const LAS bf16* ks_ = KS + cb * (64 * 136); const LAS bf16* vs_ = VS + cb * (128 * 72);
                f32x4 S[4][2];
#pragma unroll
                for (int kb = 0; kb < 4; ++kb) { S[kb][0] = (f32x4){0.f, 0.f, 0.f, 0.f}; S[kb][1] = (f32x4){0.f, 0.f, 0.f, 0.f};
#pragma unroll
                    for (int ks = 0; ks < 4; ++ks) { const bf16x8 a = *(const LAS bf16x8*)(ks_ + (16 * kb + fr) * 136 + 32 * ks + 8 * fq);
                        S[kb][0] = __builtin_amdgcn_mfma_f32_16x16x32_bf16(a, Qf[0][ks], S[kb][0], 0, 0, 0);
                        S[kb][1] = __builtin_amdgcn_mfma_f32_16x16x32_bf16(a, Qf[1][ks], S[kb][1], 0, 0, 0); }
                    __builtin_amdgcn_sched_barrier(0); }
                if (more) {
#pragma unroll
                    for (int i = 0; i < 2; ++i) *(LAS v4u*)(F.lds + nb * (64 * 136 * 2) + klo[i]) = sreg[i];
#pragma unroll
                    for (int i = 0; i < 2; ++i) sreg[i] = *(const GAS v4u*)(vg + (size_t)(kt + 1) * (64 * 2) + vgo[i]);
                }
                bf16x8 Pf[2][2];
#pragma unroll
                for (int qb = 0; qb < 2; ++qb) {
                    float mx = NEG_INF;
#pragma unroll
                    for (int kb = 0; kb < 4; ++kb)
#pragma unroll
                        for (int j = 0; j < 4; ++j) { const bool on = (mw[qb] >> (16 * kb + j)) & 1ull; const float s = on ? S[kb][qb][j] : NEG_INF; S[kb][qb][j] = s; mx = fmaxf(mx, s); }
                    mx = fmaxf(mx, __shfl_xor(mx, 16)); mx = fmaxf(mx, __shfl_xor(mx, 32));
                    const float mnew = fmaxf(mrow[qb], mx), msafe = (mnew == NEG_INF) ? 0.f : mnew;
                    const float alpha = __builtin_amdgcn_exp2f(mrow[qb] - msafe);
                    mrow[qb] = mnew;
                    float ps = 0.f; float p[4][4];
#pragma unroll
                    for (int kb = 0; kb < 4; ++kb)
#pragma unroll
                        for (int j = 0; j < 4; ++j) { p[kb][j] = __builtin_amdgcn_exp2f(S[kb][qb][j] - msafe); ps += p[kb][j]; }
                    lrow[qb] = lrow[qb] * alpha + ps;
#pragma unroll
                    for (int db = 0; db < 8; ++db) O[db][qb] = O[db][qb] * alpha;
#pragma unroll
                    for (int pp = 0; pp < 2; ++pp) { v4u o; o.x = pkbf(p[2 * pp][0], p[2 * pp][1]); o.y = pkbf(p[2 * pp][2], p[2 * pp][3]); o.z = pkbf(p[2 * pp + 1][0], p[2 * pp + 1][1]); o.w = pkbf(p[2 * pp + 1][2], p[2 * pp + 1][3]);
                        Pf[qb][pp] = __builtin_bit_cast(bf16x8, o); }
                }
#pragma unroll
                for (int db = 0; db < 8; ++db)
#pragma unroll
                    for (int pp = 0; pp < 2; ++pp) {
                        const u32x2v v0 = *(const LAS u32x2v*)(vs_ + (16 * db + fr) * 72 + 32 * pp + 4 * fq), v1 = *(const LAS u32x2v*)(vs_ + (16 * db + fr) * 72 + 32 * pp + 16 + 4 * fq);
                        v4u va; va.x = v0.x; va.y = v0.y; va.z = v1.x; va.w = v1.y; const bf16x8 a = __builtin_bit_cast(bf16x8, va);
                        O[db][0] = __builtin_amdgcn_mfma_f32_16x16x32_bf16(a, Pf[0][pp], O[db][0], 0, 0, 0);
                        O[db][1] = __builtin_amdgcn_mfma_f32_16x16x32_bf16(a, Pf[1][pp], O[db][1], 0, 0, 0);
                        if (pp == 1 && (db & 1)) __builtin_amdgcn_sched_barrier(0); }
                if (more) {
#pragma unroll
                    for (int i = 0; i < 2; ++i) *(LAS v4u*)(F.lds + nb * (128 * 72 * 2) + vlo[i]) = sreg[i];
                }
                __syncthreads();
            }
#pragma unroll
            for (int qb = 0; qb < 2; ++qb) {
                float l = lrow[qb]; l += __shfl_xor(l, 16); l += __shfl_xor(l, 32);
                const float inv = 1.0f / l;
                bf16* orow = OC + (size_t)(b * SEQ + tq0 + qb * 16 + fr) * 2048 + hq * 128 + 4 * fq;
#pragma unroll
                for (int db = 0; db < 8; ++db) { u32x2v w; w.x = pkbf(O[db][qb][0] * inv, O[db][qb][1] * inv); w.y = pkbf(O[db][qb][2] * inv, O[db][qb][3] * inv); *(GAS u32x2v*)(orow + 16 * db) = w; }
            }
        }
    }
    __syncthreads();
}
__device__ __forceinline__ void phase_post(Frame& F, const LayerIn& L) {
    OPAQUE_IDS();
    const int gw = bid * NWAVES + wave, NGW = G * NWAVES;
    const float* OAR = (const float*)(wsb + WS_OAR); const float* OBR = (const float*)(wsb + WS_OBR); const float* PA = (const float*)(wsb + WS_PA);
    const float* RKV = (const float*)(wsb + WS_RKV); const float* LO = (const float*)(wsb + WS_LO); const float* RK = (const float*)(wsb + WS_RK);
    bf16* OA = (bf16*)(wsb + WS_OA); bf16* OB = (bf16*)(wsb + WS_OB);
    for (int m = gw; m < M; m += NGW) {
        const int c0 = lane * 16;
        { float o[16]; float ss = 0.f;
#pragma unroll
          for (int i = 0; i < 4; ++i) { const f32x4 v = *(const GAS f32x4*)(OAR + (size_t)m * 1024 + c0 + 4 * i); o[4 * i] = v.x; o[4 * i + 1] = v.y; o[4 * i + 2] = v.z; o[4 * i + 3] = v.w; ss += (v.x * v.x + v.y * v.y) + (v.z * v.z + v.w * v.w); }
          ss += __shfl_xor(ss, 1); ss += __shfl_xor(ss, 2); ss += __shfl_xor(ss, 4);
          const float rinv = 1.0f / sqrtf(ss * (1.0f / 128.0f) + NORM_EPS);
          float y[16];
#pragma unroll
          for (int i = 0; i < 4; ++i) { const f32x4 gn = *(const GAS f32x4*)(L.out_norm + (lane & 7) * 16 + 4 * i), gg = *(const GAS f32x4*)(PA + (size_t)m * LDPA + 3072 + c0 + 4 * i);
#pragma unroll
              for (int j = 0; j < 4; ++j) { const float g = gg[j]; y[4 * i + j] = o[4 * i + j] * rinv * gn[j] * (g / (1.0f + __expf(-g))); } }
#pragma unroll
          for (int i = 0; i < 2; ++i) { v4u w; w.x = pkbf(y[8 * i], y[8 * i + 1]); w.y = pkbf(y[8 * i + 2], y[8 * i + 3]); w.z = pkbf(y[8 * i + 4], y[8 * i + 5]); w.w = pkbf(y[8 * i + 6], y[8 * i + 7]);
              *(GAS v4u*)(OA + (size_t)m * 1024 + c0 + 8 * i) = w; } }
        { float o[16]; float s1 = 0.f;
#pragma unroll
          for (int i = 0; i < 4; ++i) { const f32x4 v = *(const GAS f32x4*)(OBR + (size_t)m * 1024 + c0 + 4 * i); o[4 * i] = v.x; o[4 * i + 1] = v.y; o[4 * i + 2] = v.z; o[4 * i + 3] = v.w; s1 += (v.x + v.y) + (v.z + v.w); }
          s1 += __shfl_xor(s1, 1); s1 += __shfl_xor(s1, 2);
          const float mean = s1 * (1.0f / 64.0f); float s2 = 0.f;
#pragma unroll
          for (int i = 0; i < 16; ++i) { o[i] -= mean; s2 += o[i] * o[i]; }
          s2 += __shfl_xor(s2, 1); s2 += __shfl_xor(s2, 2);
          const float rstd = 1.0f / sqrtf(s2 * (1.0f / 64.0f) + 64e-5f);
          const float rk = RK[(size_t)m * 16 + (lane >> 2)];
          float y[16];
#pragma unroll
          for (int i = 0; i < 4; ++i) { const f32x4 lw = *(const GAS f32x4*)(L.ln_w + c0 + 4 * i), lbv = *(const GAS f32x4*)(L.ln_b + c0 + 4 * i);
              const f32x4 vv = *(const GAS f32x4*)(RKV + (size_t)m * 3072 + 2048 + c0 + 4 * i), gg = *(const GAS f32x4*)(LO + (size_t)m * 3072 + 2048 + c0 + 4 * i);
#pragma unroll
              for (int j = 0; j < 4; ++j) y[4 * i + j] = (o[4 * i + j] * rstd * lw[j] + lbv[j] + rk * vv[j]) * gg[j]; }
#pragma unroll
          for (int i = 0; i < 2; ++i) { v4u w; w.x = pkbf(y[8 * i], y[8 * i + 1]); w.y = pkbf(y[8 * i + 2], y[8 * i + 3]); w.z = pkbf(y[8 * i + 4], y[8 * i + 5]); w.w = pkbf(y[8 * i + 6], y[8 * i + 7]);
              *(GAS v4u*)(OB + (size_t)m * 1024 + c0 + 8 * i) = w; } }
    }
}
__device__ __forceinline__ f32x4 bf4_to_f32(u32x2v w) { f32x4 r; r.x = __uint_as_float(w.x << 16); r.y = __uint_as_float(w.x & 0xffff0000u); r.z = __uint_as_float(w.y << 16); r.w = __uint_as_float(w.y & 0xffff0000u); return r; }
__device__ __forceinline__ void phase_convact(Frame& F, const LayerIn& L) {
    OPAQUE_IDS();
    const int gw = bid * NWAVES + wave, NGW = G * NWAVES;
    const bf16* U = (const bf16*)(wsb + WS_U); bf16* ACT = (bf16*)(wsb + WS_ACT);
    constexpr int NSTRIP = DFF / 256, NRUN = M / 32;
    for (int it = gw; it < NSTRIP * NRUN; it += NGW) {
        const int sp = it % NSTRIP, rn = it / NSTRIP, c = sp * 256 + lane * 4, m0 = rn * 32;
        f32x4 wg[3], wu[3];
#pragma unroll
        for (int j = 0; j < 3; ++j) { wg[j] = *(const GAS f32x4*)(L.conv_w + (size_t)j * NUP + c); wu[j] = *(const GAS f32x4*)(L.conv_w + (size_t)j * NUP + DFF + c); }
        const f32x4 bg = *(const GAS f32x4*)(L.conv_b + c), bu = *(const GAS f32x4*)(L.conv_b + DFF + c);
        f32x4 g2 = (f32x4){0.f, 0.f, 0.f, 0.f}, g1 = g2, u2 = g2, u1 = g2;
        if ((m0 % SEQ) != 0) {
            g2 = bf4_to_f32(*(const GAS u32x2v*)(U + (size_t)(m0 - 2) * NUP + c)); g1 = bf4_to_f32(*(const GAS u32x2v*)(U + (size_t)(m0 - 1) * NUP + c));
            u2 = bf4_to_f32(*(const GAS u32x2v*)(U + (size_t)(m0 - 2) * NUP + DFF + c)); u1 = bf4_to_f32(*(const GAS u32x2v*)(U + (size_t)(m0 - 1) * NUP + DFF + c)); }
#pragma unroll 4
        for (int tt = 0; tt < 32; ++tt) {
            const size_t m = (size_t)(m0 + tt);
            const f32x4 g0 = bf4_to_f32(*(const GAS u32x2v*)(U + m * NUP + c)), u0 = bf4_to_f32(*(const GAS u32x2v*)(U + m * NUP + DFF + c));
            const f32x4 gc = wg[0] * g2 + wg[1] * g1 + wg[2] * g0 + bg, uc = wu[0] * u2 + wu[1] * u1 + wu[2] * u0 + bu;
            f32x4 a;
#pragma unroll
            for (int j = 0; j < 4; ++j) a[j] = (gc[j] / (1.0f + __expf(-gc[j]))) * uc[j];
            u32x2v w; w.x = pkbf(a[0], a[1]); w.y = pkbf(a[2], a[3]);
            *(GAS u32x2v*)(ACT + m * DFF + c) = w;
            g2 = g1; g1 = g0; u2 = u1; u1 = u0;
        }
    }
}
#ifndef MK_PER_PHASE
#define MK_PER_PHASE 1
#endif
constexpr int NPH = 14;
struct Args { const void* in[28]; float* out; unsigned char* ws; int ph_lo, ph_hi; };
__device__ __forceinline__ LayerIn make_layer(const Args& args, int layer) {
    LayerIn L;
    L.norm_mix = (const float*)args.in[2] + (size_t)layer * DM; L.w_in = (const float*)args.in[3] + (size_t)layer * DM * IN_COLS;
    L.lb0 = (const float*)args.in[4]; L.lb1 = (const float*)args.in[4] + 1024; L.out_norm = (const float*)args.in[5] + (size_t)layer * 128;
    L.mu = (const float*)args.in[6] + (size_t)layer * 3360; L.w0 = (const float*)args.in[7] + (size_t)layer * 1024; L.w2 = (const float*)args.in[8] + (size_t)layer * 64 * 1024;
    L.a0 = (const float*)args.in[9] + (size_t)layer * 1024; L.a2 = (const float*)args.in[10] + (size_t)layer * 64 * 1024; L.g2 = (const float*)args.in[11] + (size_t)layer * 160 * 1024;
    L.k_k = (const float*)args.in[12] + (size_t)layer * 1024; L.k_a = (const float*)args.in[13] + (size_t)layer * 1024; L.r_k = (const float*)args.in[14] + (size_t)layer * 1024;
    L.ln_w = (const float*)args.in[15] + (size_t)layer * 1024; L.ln_b = (const float*)args.in[16] + (size_t)layer * 1024;
    L.q_norm = (const float*)args.in[17] + (size_t)layer * 128; L.k_norm = (const float*)args.in[18] + (size_t)layer * 128;
    L.wba = (const float*)args.in[19] + (size_t)layer * 1024 * DM; L.wbb = (const float*)args.in[20] + (size_t)layer * 1024 * DM; L.wbc = (const float*)args.in[21] + (size_t)layer * 2048 * DM;
    L.w_out = (const float*)args.in[22] + (size_t)layer * DM * DM; L.norm_ffn = (const float*)args.in[23] + (size_t)layer * DM;
    L.w_up = (const float*)args.in[24] + (size_t)layer * DM * NUP; L.conv_w = (const float*)args.in[25] + (size_t)layer * 3 * NUP; L.conv_b = (const float*)args.in[26] + (size_t)layer * NUP;
    L.w_down = (const float*)args.in[27] + (size_t)layer * DFF * DM;
    return L;
}
__global__ void __launch_bounds__(NWAVES * 64, 2) mk_fwd(Args args) {
    extern __shared__ __attribute__((aligned(16))) unsigned char lds[];
    Frame F;
    F.lds = (LAS unsigned char*)lds;
    F.MISC = (volatile LAS unsigned*)(F.lds + MISC_OFF);
    F.tid = threadIdx.x; F.lane = F.tid & 63; F.wave = __builtin_amdgcn_readfirstlane(F.tid >> 6);
    F.G = gridDim.x; F.ws = args.ws; F.ctl = (gu32*)(args.ws + WS_CTL);
    for (int u = F.tid; u < (LDS_BYTES - LDSCTL_OFF) / 4; u += NWAVES * 64) ((LAS unsigned*)(F.lds + LDSCTL_OFF))[u] = 0u;
    __syncthreads();
    XcdBarrier bar; bar.bar = (unsigned*)(F.ctl + CW_BAR); bar.x = 0; bar.st = nullptr;
    if (!MK_PER_PHASE) bar = xcd_barrier_post((unsigned*)(F.ctl + CW_BAR), F.MISC + 8);
    const int lo = args.ph_lo, hi = args.ph_hi;
    float* xout = args.out;

    if (lo == 0) phase_rope_tables(F, (const int*)args.in[1]);
    for (int layer = 0; layer < 2; ++layer) {
        const float* xin = (layer == 0) ? (const float*)args.in[0] : (const float*)xout;
        const int pbase = layer * NPH;
#ifndef ONLY
#define ONLY -1
#endif
#define IN(k) ((ONLY < 0 || ONLY == (k)) && lo <= pbase + (k) && pbase + (k) < hi)
#define WSL() unsigned char* wsb = args.ws; asm volatile("" : "+s"(wsb)); int bid = blockIdx.x; asm volatile("" : "+s"(bid)); int GG = F.G; asm volatile("" : "+s"(GG)); int wv = F.wave; asm volatile("" : "+s"(wv)); (void)bid; (void)GG; (void)wv; bf16* const XB = (bf16*)(wsb + WS_XB); const float* const RS = (const float*)(wsb + WS_RS); (void)XB; (void)RS
#define SEAM(k) do { if (!MK_PER_PHASE && (pbase + (k) + 1 < hi)) xcd_barrier(bar); } while (0)

        if (IN(0)) { WSL(); { const LayerIn L = make_layer(args, layer); phase_weights(F, L); } phase_norm(F, xin); __syncthreads(); SEAM(0); }
        if (IN(1)) { WSL();
#if !defined(SUB) || SUB==1
            { pg8::Gemm g{XB, (const bf16*)(wsb + WS_WIN), M, NA1, DM}; pg8::StaticOrder S; S.init(M, NA1, GG, bid);
              pg8::EpiP1 E{(float*)(wsb + WS_PA), (float*)(wsb + WS_PB), (float*)(wsb + WS_PC), RS};
              pg8::gemm_phase<pg8::EpiP1, pg8::StaticOrder, true, true>(F.lds + RING_OFF, g, S, E, wv); }
            __syncthreads();
#endif
        }
        if (IN(1)) { WSL();
#if !defined(SUB) || SUB==2
            { pg8::Gemm g{XB, (const bf16*)(wsb + WS_WIN) + (size_t)NA1 * DM, M, NGT, DM}; pg8::StaticOrder S; S.init(M, NGT, GG, bid);
              pg8::EpiB16<1> E{(bf16*)(wsb + WS_G), NGT, RS};
              pg8::gemm_phase<pg8::EpiB16<1>, pg8::StaticOrder, true, true>(F.lds + RING_OFF, g, S, E, wv); }
#endif
            __syncthreads(); SEAM(1);
        }
        if (IN(2)) { WSL(); { const LayerIn L = make_layer(args, layer); phase_prep(F, L); } SEAM(2); }
        if (IN(3)) { WSL();
#if !defined(SUB) || SUB==1
            { pg8::Gemm g{(const bf16*)(wsb + WS_LA), (const bf16*)(wsb + WS_WLORA), M, NLORA, KLORA}; pg8::StaticOrder S; S.init(M, NLORA, GG, bid);
              pg8::EpiF32 E{(float*)(wsb + WS_LO), NLORA};
              pg8::gemm_phase<pg8::EpiF32, pg8::StaticOrder, true, true>(F.lds + RING_OFF, g, S, E, wv); }
#endif
            __syncthreads();
#if !defined(SUB) || SUB==2
            phase_indexer(F);
#endif
            SEAM(3);
        }
        if (IN(4)) { WSL(); { const LayerIn L = make_layer(args, layer); phase_bprep2(F, L); } phase_select(F); SEAM(4); }
        if (IN(5)) { WSL(); __syncthreads();
#if !defined(SUB) || SUB==1
            phase_scan(F);
#endif
#if !defined(SUB) || SUB==2
            { const LayerIn L = make_layer(args, layer); phase_hgrn(F, L, layer); }
#endif
#if !defined(SUB) || SUB==3
            phase_attn(F);
#endif
            SEAM(5); }
        if (IN(6)) { WSL(); { const LayerIn L = make_layer(args, layer); phase_post(F, L); } SEAM(6); }
        if (IN(7)) { WSL();
            __syncthreads();
            { pg8::Gemm g{(const bf16*)(wsb + WS_OA), (const bf16*)(wsb + WS_WA), M, DM, 1024}; pg8::StaticOrder S; S.init(M, DM, GG, bid);
              pg8::EpiMerge<0> E{(float*)(wsb + WS_MG), nullptr, (const bf16*)(wsb + WS_G), 0};
              pg8::gemm_phase<pg8::EpiMerge<0>, pg8::StaticOrder, true, true>(F.lds + RING_OFF, g, S, E, wv); }
            __syncthreads();
            { pg8::Gemm g{(const bf16*)(wsb + WS_OB), (const bf16*)(wsb + WS_WB), M, DM, 1024}; pg8::StaticOrder S; S.init(M, DM, GG, bid);
              pg8::EpiMerge<1> E{(float*)(wsb + WS_MG), nullptr, (const bf16*)(wsb + WS_G), 4096};
              pg8::gemm_phase<pg8::EpiMerge<1>, pg8::StaticOrder, true, true>(F.lds + RING_OFF, g, S, E, wv); }
            __syncthreads();
            { pg8::Gemm g{(const bf16*)(wsb + WS_OC), (const bf16*)(wsb + WS_WC), M, DM, 2048}; pg8::StaticOrder S; S.init(M, DM, GG, bid);
              pg8::EpiMerge<2> E{(float*)(wsb + WS_MG), (bf16*)(wsb + WS_MERGED), (const bf16*)(wsb + WS_G), 8192};
              pg8::gemm_phase<pg8::EpiMerge<2>, pg8::StaticOrder, true, true>(F.lds + RING_OFF, g, S, E, wv); }
            __syncthreads(); SEAM(7);
        }
        if (IN(8)) { WSL();
            __syncthreads();
            { pg8::Gemm g{(const bf16*)(wsb + WS_MERGED), (const bf16*)(wsb + WS_WOUT), M, DM, DM}; pg8::StaticOrder S; S.init(M, DM, GG, bid);
              pg8::EpiRes E{xin, xout, DM};
              pg8::gemm_phase<pg8::EpiRes, pg8::StaticOrder, true, true>(F.lds + RING_OFF, g, S, E, wv); }
            __syncthreads(); SEAM(8);
        }
        if (IN(9)) { WSL(); phase_norm(F, xout); SEAM(9); }
        if (IN(10)) { WSL();
            __syncthreads();
            { pg8::Gemm g{XB, (const bf16*)(wsb + WS_WUP), M, NUP, DM}; pg8::StaticOrder S; S.init(M, NUP, GG, bid);
              pg8::EpiB16<0> E{(bf16*)(wsb + WS_U), NUP, RS};
              pg8::gemm_phase<pg8::EpiB16<0>, pg8::StaticOrder, true, true>(F.lds + RING_OFF, g, S, E, wv); }
            __syncthreads(); SEAM(10);
        }
        if (IN(11)) { WSL(); { const LayerIn L = make_layer(args, layer); phase_convact(F, L); } SEAM(11); }
        if (IN(12)) { WSL();
            __syncthreads();
            { pg8::Gemm g{(const bf16*)(wsb + WS_ACT), (const bf16*)(wsb + WS_WDN), M, DM, DFF}; pg8::StaticOrder S; S.init(M, DM, GG, bid);
              pg8::EpiRes E{xout, xout, DM};
              pg8::gemm_phase<pg8::EpiRes, pg8::StaticOrder, true, true>(F.lds + RING_OFF, g, S, E, wv); }
            __syncthreads(); SEAM(12);
        }
        if (IN(13)) { WSL(); SEAM(13); }
#undef IN
#undef SEAM
    }
}

extern "C" void kernel_launch(void* const* d_in, const int* in_sizes, int n_in, void* d_out, int out_size, void* d_ws, size_t ws_size, hipStream_t stream) {
    static int grid = 0;
    if (grid == 0) {
        if (n_in != 28 || out_size != M * DM || ws_size < WS_END) { fprintf(stderr, "kernel_launch: unexpected problem (n_in %d, out %d, ws %zu < %zu); nothing launched\n", n_in, out_size, ws_size, (size_t)WS_END); grid = -1; return; }
        int dev = 0, cus = 0, per_cu = 0;
        if (hipGetDevice(&dev) != hipSuccess || hipDeviceGetAttribute(&cus, hipDeviceAttributeMultiprocessorCount, dev) != hipSuccess) { grid = -1; return; }
        if (hipFuncSetAttribute((const void*)mk_fwd, hipFuncAttributeMaxDynamicSharedMemorySize, LDS_BYTES) != hipSuccess) { fprintf(stderr, "kernel_launch: hipFuncSetAttribute failed\n"); grid = -1; return; }
        if (hipOccupancyMaxActiveBlocksPerMultiprocessor(&per_cu, (const void*)mk_fwd, NWAVES * 64, LDS_BYTES) != hipSuccess || per_cu < 1)
            fprintf(stderr, "kernel_launch: note: occupancy query reports %d workgroups per CU\n", per_cu);
        (void)hipGetLastError();
        grid = cus;
    }
    if (grid < 0) return;
    if (hipMemsetAsync((char*)d_ws + WS_CTL, 0, CTL_ZERO_BYTES, stream) != hipSuccess) { fprintf(stderr, "kernel_launch: memset failed\n"); return; }
    Args a{};
    for (int i = 0; i < 28; ++i) a.in[i] = d_in[i];
    a.out = (float*)d_out; a.ws = (unsigned char*)d_ws;
#if MK_PER_PHASE
    for (int p = 0; p < 2 * NPH; ++p) { if (p % NPH == 13) continue; a.ph_lo = p; a.ph_hi = p + 1; hipLaunchKernelGGL(mk_fwd, dim3(grid), dim3(NWAVES * 64), LDS_BYTES, stream, a); }
#else
    a.ph_lo = 0; a.ph_hi = 2 * NPH;
    hipLaunchKernelGGL(mk_fwd, dim3(grid), dim3(NWAVES * 64), LDS_BYTES, stream, a);
#endif
    const hipError_t le = hipPeekAtLastError();
    if (le != hipSuccess) fprintf(stderr, "kernel_launch: launch failed: %s\n", hipGetErrorName(le));
}
```

```cpp
#include <hip/hip_runtime.h>
#include <cstdio>
#include <cstdint>
namespace pg8 {
#define PG8_LAS __attribute__((address_space(3)))
typedef unsigned short bf16_t;
typedef short bf16x8 __attribute__((ext_vector_type(8)));
typedef float f32x4 __attribute__((ext_vector_type(4)));
typedef unsigned u32x4 __attribute__((ext_vector_type(4)));
constexpr int BM = 256, BK = 64, HALF = 128, HTB = HALF * BK * 2  , STAGE_BYTES = 8 * HTB, NXCD = 8, WGM = 8;

__host__ __device__ __forceinline__ int lds_byte(int r, int c) { const int st = (r >> 4) * 2 + (c >> 5), rr = r & 15, cc = c & 31, ob = rr * 64 + cc * 2; return st * 1024 + (ob ^ (((ob >> 9) & 1) << 5)); }
__host__ __device__ __forceinline__ void stage_rc(int b, int& R, int& C) { const int st = b / 1024, sb = b % 1024, swz = sb ^ (((sb >> 9) & 1) << 5); R = (st >> 1) * 16 + swz / 64; C = (st & 1) * 32 + (swz % 64) / 2; }
__host__ __device__ __forceinline__ int perm32(int rho) { const int n = rho >> 4, i = rho & 15; return 8 * (i >> 2) + 4 * n + (i & 3); }

struct Unit { int pm, pn, seg; };
struct Gemm { const bf16_t* A; const bf16_t* Bt; int M, N, K; };

struct StaticOrder {
    int nM, nN, nwg, G, c;
    __host__ __device__ void init(int M, int N, int G_, int c_) { nM = M / BM; nN = N / BM; nwg = nM * nN; G = G_; c = c_; }
    __host__ __device__ __forceinline__ bool next(int i, Unit& u) const {
        const long L = (long)i * G + c; if (L >= nwg) return false;
        int wgid = (int)L; { const int q = nwg / NXCD, r = nwg % NXCD, xcd = wgid % NXCD, off = wgid / NXCD; wgid = (xcd < r ? xcd * (q + 1) : r * (q + 1) + (xcd - r) * q) + off; }
        const int nig = WGM * nN, gid = wgid / nig, fm = gid * WGM, gsz = (nM - fm) < WGM ? (nM - fm) : WGM;
        u.pm = fm + ((wgid % nig) % gsz); u.pn = (wgid % nig) / gsz; return true;
    }
    __device__ __forceinline__ void a_ready(const Unit&) const {}
    __device__ __forceinline__ void done(const Unit&) const {}
    __device__ __forceinline__ const bf16_t* a_base(const Gemm& g, const Unit&) const { return g.A; }
    __device__ __forceinline__ const bf16_t* b_base(const Gemm& g, const Unit&) const { return g.Bt; }
    __device__ __forceinline__ int ntiles(const Unit&, int nt) const { return nt; }
    __device__ __forceinline__ bool keep(const Unit&) const { return false; }
};
struct SplitTailOrder : StaticOrder {
    __host__ __device__ __forceinline__ bool split() const { return (nwg - (nwg / G) * G) * 2 == G; }
    __host__ __device__ __forceinline__ bool next(int i, Unit& u) const {
        const int R = nwg / G; u.seg = 0;
        if (i < R || !split()) return StaticOrder::next(i, u);
        if (i > R) return false;
        const int half = G >> 1; StaticOrder T = *this; T.c = c % half; u.seg = 1 + c / half; return T.next(R, u);
    }
    __device__ __forceinline__ const bf16_t* a_base(const Gemm& g, const Unit& u) const { return g.A + (u.seg == 2 ? (g.K >> 1) : 0); }
    __device__ __forceinline__ const bf16_t* b_base(const Gemm& g, const Unit& u) const { return g.Bt + (u.seg == 2 ? (g.K >> 1) : 0); }
    __device__ __forceinline__ int ntiles(const Unit& u, int nt) const { return u.seg ? (nt >> 1) : nt; }
};
struct MergeOrder : StaticOrder {
    const bf16_t *A0, *B0; size_t sA, sB;
    __device__ __forceinline__ bool next(int i, Unit& u) const { const bool ok = StaticOrder::next(i / 3, u); u.seg = i % 3; return ok; }
    __device__ __forceinline__ const bf16_t* a_base(const Gemm&, const Unit& u) const { return A0 + (size_t)u.seg * sA; }
    __device__ __forceinline__ const bf16_t* b_base(const Gemm&, const Unit& u) const { return B0 + (size_t)u.seg * sB; }
    __device__ __forceinline__ int ntiles(const Unit& u, int) const { return u.seg == 2 ? 32 : 16; }
    __device__ __forceinline__ bool keep(const Unit& u) const { return u.seg < 2; }
};

typedef __bf16 bf16x2_t __attribute__((ext_vector_type(2)));
__device__ __forceinline__ unsigned cvt_pk_bf16(float lo, float hi) { bf16x2_t v; v.x = (__bf16)lo; v.y = (__bf16)hi; return __builtin_bit_cast(unsigned, v); }
typedef unsigned u32x2 __attribute__((ext_vector_type(2)));
#ifndef WT_EPI
#define WT_EPI 0
#endif
__device__ __forceinline__ void st16(const void* base, int byteoff, u32x4 w) {
#if WT_EPI
    const __amdgpu_buffer_rsrc_t r = __builtin_amdgcn_make_buffer_rsrc((void*)base, (short)0, 0x7FFFF000, 0x00020000);
    __builtin_amdgcn_raw_buffer_store_b128(w, r, byteoff, 0, 16);
#else
    *(u32x4*)((char*)base + byteoff) = w;
#endif
}
__device__ __forceinline__ float fsigmoid(float x) { return __builtin_amdgcn_rcpf(1.0f + __expf(-x)); }

struct EpiP1 {
    static constexpr bool PERM = true, AFTER_DRAIN = false;
    bf16_t* PA; float* PAF; bf16_t* PB; bf16_t* PC; const float* rs;
    __device__ __forceinline__ void operator()(const f32x4 (&acc)[2][2][4][2], const Unit& u, int wr, int wc, int fr, int fq) const {
        bf16_t* base; int ld, colt; const bool f32out = (u.pn >= 4 && u.pn < 8);
        if (u.pn < 16) { base = PA; ld = 4096; colt = u.pn * BM; } else if (u.pn < 30) { base = PB; ld = 3584; colt = (u.pn - 16) * BM; } else { base = PC; ld = 4352; colt = (u.pn - 30) * BM; }
        const int row0 = u.pm * BM + wr * 64 + fr, col0 = colt + wc * 32 + 8 * fq;
        float sc[2][4];
#pragma unroll
        for (int ai = 0; ai < 2; ++ai)
#pragma unroll
            for (int m = 0; m < 4; ++m) sc[ai][m] = 1.0f / __builtin_sqrtf(rs[row0 + ai * HALF + m * 16] * (1.0f / 4096.0f) + 1e-6f);
        const int fcol0 = (u.pn - 4) * BM + wc * 32 + 8 * fq;
#pragma unroll
        for (int ai = 0; ai < 2; ++ai)
#pragma unroll
            for (int m = 0; m < 4; ++m) { const int row = row0 + ai * HALF + m * 16; const float s = sc[ai][m]; const int ob = (row * ld + col0) * 2, of = (row * 1024 + fcol0) * 4;
#pragma unroll
                for (int bj = 0; bj < 2; ++bj) { const f32x4 v0 = acc[ai][bj][m][0] * s, v1 = acc[ai][bj][m][1] * s;
                    if (f32out) { st16(PAF, of + bj * HALF * 4, __builtin_bit_cast(u32x4, v0)); st16(PAF, of + bj * HALF * 4 + 16, __builtin_bit_cast(u32x4, v1)); }
                    else { u32x4 w; w.x = cvt_pk_bf16(v0[0], v0[1]); w.y = cvt_pk_bf16(v0[2], v0[3]); w.z = cvt_pk_bf16(v1[0], v1[1]); w.w = cvt_pk_bf16(v1[2], v1[3]); st16(base, ob + bj * HALF * 2, w); } } }
    }
};
template <int ACT> struct EpiB16 {
    static constexpr bool PERM = true, AFTER_DRAIN = false;
    bf16_t* O; int ldc; const float* rs;
    __device__ __forceinline__ void operator()(const f32x4 (&acc)[2][2][4][2], const Unit& u, int wr, int wc, int fr, int fq) const {
        const int row0 = u.pm * BM + wr * 64 + fr, col0 = u.pn * BM + wc * 32 + 8 * fq;
        float sc[2][4];
#pragma unroll
        for (int ai = 0; ai < 2; ++ai)
#pragma unroll
            for (int m = 0; m < 4; ++m) sc[ai][m] = 1.0f / __builtin_sqrtf(rs[row0 + ai * HALF + m * 16] * (1.0f / 4096.0f) + 1e-6f);
#pragma unroll
        for (int ai = 0; ai < 2; ++ai)
#pragma unroll
            for (int m = 0; m < 4; ++m) { const int row = row0 + ai * HALF + m * 16; const float s = sc[ai][m]; const int ob = (row * ldc + col0) * 2;
#pragma unroll
                for (int bj = 0; bj < 2; ++bj) { f32x4 v0 = acc[ai][bj][m][0] * s, v1 = acc[ai][bj][m][1] * s;
                    if (ACT == 1) {
#pragma unroll
                        for (int j = 0; j < 4; ++j) { v0[j] = fsigmoid(v0[j]); v1[j] = fsigmoid(v1[j]); } }
                    u32x4 w; w.x = cvt_pk_bf16(v0[0], v0[1]); w.y = cvt_pk_bf16(v0[2], v0[3]); w.z = cvt_pk_bf16(v1[0], v1[1]); w.w = cvt_pk_bf16(v1[2], v1[3]);
                    st16(O, ob + bj * HALF * 2, w); } }
    }
};
struct EpiB16Plain {
    static constexpr bool PERM = true, AFTER_DRAIN = false;
    bf16_t* O; int ldc;
    __device__ __forceinline__ void operator()(const f32x4 (&acc)[2][2][4][2], const Unit& u, int wr, int wc, int fr, int fq) const {
        const int row0 = u.pm * BM + wr * 64 + fr, col0 = u.pn * BM + wc * 32 + 8 * fq;
#pragma unroll
        for (int ai = 0; ai < 2; ++ai)
#pragma unroll
            for (int m = 0; m < 4; ++m) { const int ob = ((row0 + ai * HALF + m * 16) * ldc + col0) * 2;
#pragma unroll
                for (int bj = 0; bj < 2; ++bj) { const f32x4 v0 = acc[ai][bj][m][0], v1 = acc[ai][bj][m][1];
                    u32x4 w; w.x = cvt_pk_bf16(v0[0], v0[1]); w.y = cvt_pk_bf16(v0[2], v0[3]); w.z = cvt_pk_bf16(v1[0], v1[1]); w.w = cvt_pk_bf16(v1[2], v1[3]);
                    st16(O, ob + bj * HALF * 2, w); } }
    }
};
struct EpiF32 {
    static constexpr bool PERM = false, AFTER_DRAIN = false;
    float* C; int ldc;
    __device__ __forceinline__ void operator()(const f32x4 (&acc)[2][2][4][2], const Unit& u, int wr, int wc, int fr, int fq) const {
        const int row0 = u.pm * BM + wr * 64 + fr, col0 = u.pn * BM + wc * 32 + 4 * fq;
#pragma unroll
        for (int ai = 0; ai < 2; ++ai)
#pragma unroll
            for (int m = 0; m < 4; ++m) { float* rowp = C + (size_t)(row0 + ai * HALF + m * 16) * ldc + col0;
#pragma unroll
                for (int bj = 0; bj < 2; ++bj)
#pragma unroll
                    for (int n = 0; n < 2; ++n) *(f32x4*)(rowp + bj * HALF + n * 16) = acc[ai][bj][m][n]; }
    }
};
template <int MODE> struct EpiMerge {
    static constexpr bool PERM = true, AFTER_DRAIN = false;
    bf16_t* MG; bf16_t* OUT; const bf16_t* G; int goff;
    __device__ __forceinline__ void operator()(const f32x4 (&acc)[2][2][4][2], const Unit& u, int wr, int wc, int fr, int fq) const {
        const int row0 = u.pm * BM + wr * 64 + fr, col0 = u.pn * BM + wc * 32 + 8 * fq;
        u32x4 gcur[2], gnxt[2], mcur[2], mnxt[2];
#define EM_LOAD(gdst, mdst, g_) do { const size_t row_ = (size_t)(row0 + ((g_) >> 2) * HALF + ((g_) & 3) * 16); _Pragma("unroll") for (int q_ = 0; q_ < 2; ++q_) { const int col_ = col0 + q_ * HALF; \
            gdst[q_] = *(const u32x4*)(G + row_ * 12288 + goff + col_); if (MODE >= 1) mdst[q_] = *(const u32x4*)(MG + row_ * 4096 + col_); } } while (0)
#define EM_UNPK(lo, hi, src_) do { const u32x4 t_ = (src_); lo[0] = __uint_as_float(t_[0] << 16); lo[1] = __uint_as_float(t_[0] & 0xffff0000u); lo[2] = __uint_as_float(t_[1] << 16); lo[3] = __uint_as_float(t_[1] & 0xffff0000u); \
            hi[0] = __uint_as_float(t_[2] << 16); hi[1] = __uint_as_float(t_[2] & 0xffff0000u); hi[2] = __uint_as_float(t_[3] << 16); hi[3] = __uint_as_float(t_[3] & 0xffff0000u); } while (0)
        EM_LOAD(gcur, mcur, 0);
#pragma unroll
        for (int g = 0; g < 8; ++g) {
            if (g + 1 < 8) EM_LOAD(gnxt, mnxt, g + 1);
            const int ai = g >> 2, m = g & 3; const size_t row = (size_t)(row0 + ai * HALF + m * 16);
#pragma unroll
            for (int bj = 0; bj < 2; ++bj) { const int col = col0 + bj * HALF;
                f32x4 g0, g1; EM_UNPK(g0, g1, gcur[bj]);
                f32x4 v0 = acc[ai][bj][m][0] * g0, v1 = acc[ai][bj][m][1] * g1;
                if (MODE >= 1) { f32x4 m0, m1; EM_UNPK(m0, m1, mcur[bj]); v0 = v0 + m0; v1 = v1 + m1; }
                u32x4 w; w.x = cvt_pk_bf16(v0[0], v0[1]); w.y = cvt_pk_bf16(v0[2], v0[3]); w.z = cvt_pk_bf16(v1[0], v1[1]); w.w = cvt_pk_bf16(v1[2], v1[3]);
                if (MODE <= 1) *(u32x4*)(MG + row * 4096 + col) = w; else *(u32x4*)(OUT + row * 4096 + col) = w; }
#pragma unroll
            for (int q = 0; q < 2; ++q) { gcur[q] = gnxt[q]; mcur[q] = mnxt[q]; }
        }
#undef EM_LOAD
#undef EM_UNPK
    }
};
struct EpiMerge3 {
    static constexpr bool PERM = true, AFTER_DRAIN = false;
    bf16_t* OUT; const bf16_t* G;
    __device__ __forceinline__ void operator()(f32x4 (&acc)[2][2][4][2], const Unit& u, int wr, int wc, int fr, int fq) const {
        const int row0 = u.pm * BM + wr * 64 + fr, col0 = u.pn * BM + wc * 32 + 8 * fq; const int seg = u.seg;
        const int gnum = (seg == 0 ? 0 : (seg == 1 ? 4096 : 8192)), gden = (seg == 0 ? 4096 : 8192);
        u32x4 ncur[2], nnxt[2], dcur[2], dnxt[2];
#define E3_LOAD(nd, dd, g_) do { const size_t row_ = (size_t)(row0 + ((g_) >> 2) * HALF + ((g_) & 3) * 16); _Pragma("unroll") for (int q_ = 0; q_ < 2; ++q_) { const int col_ = col0 + q_ * HALF; \
            nd[q_] = *(const u32x4*)(G + row_ * 12288 + gnum + col_); dd[q_] = *(const u32x4*)(G + row_ * 12288 + gden + col_); } } while (0)
#define E3_UNPK(lo, hi, src_) do { const u32x4 t_ = (src_); lo[0] = __uint_as_float(t_[0] << 16); lo[1] = __uint_as_float(t_[0] & 0xffff0000u); lo[2] = __uint_as_float(t_[1] << 16); lo[3] = __uint_as_float(t_[1] & 0xffff0000u); \
            hi[0] = __uint_as_float(t_[2] << 16); hi[1] = __uint_as_float(t_[2] & 0xffff0000u); hi[2] = __uint_as_float(t_[3] << 16); hi[3] = __uint_as_float(t_[3] & 0xffff0000u); } while (0)
        E3_LOAD(ncur, dcur, 0);
#pragma unroll
        for (int g = 0; g < 8; ++g) {
            if (g + 1 < 8) E3_LOAD(nnxt, dnxt, g + 1);
            const int ai = g >> 2, m = g & 3; const size_t row = (size_t)(row0 + ai * HALF + m * 16);
#pragma unroll
            for (int bj = 0; bj < 2; ++bj) {
                f32x4 n0, n1, d0, d1; E3_UNPK(n0, n1, ncur[bj]); E3_UNPK(d0, d1, dcur[bj]);
                if (seg > 0) {
#pragma unroll
                    for (int j = 0; j < 4; ++j) { n0[j] = fmaxf(n0[j], 1e-6f); n1[j] = fmaxf(n1[j], 1e-6f); } }
                if (seg < 2) {
#pragma unroll
                    for (int j = 0; j < 4; ++j) { acc[ai][bj][m][0][j] *= n0[j] * __builtin_amdgcn_rcpf(fmaxf(d0[j], 1e-6f)); acc[ai][bj][m][1][j] *= n1[j] * __builtin_amdgcn_rcpf(fmaxf(d1[j], 1e-6f)); }
                } else {
                    const f32x4 v0 = acc[ai][bj][m][0] * n0, v1 = acc[ai][bj][m][1] * n1;
                    u32x4 w; w.x = cvt_pk_bf16(v0[0], v0[1]); w.y = cvt_pk_bf16(v0[2], v0[3]); w.z = cvt_pk_bf16(v1[0], v1[1]); w.w = cvt_pk_bf16(v1[2], v1[3]);
                    st16(OUT, (int)((row * 4096 + col0 + bj * HALF) * 2), w); }
            }
#pragma unroll
            for (int q = 0; q < 2; ++q) { ncur[q] = nnxt[q]; dcur[q] = dnxt[q]; }
        }
#undef E3_LOAD
#undef E3_UNPK
    }
};
struct EpiRes {
    static constexpr bool PERM = false, AFTER_DRAIN = false;
    const float* base; float* out; int ldc; bf16_t* xb; float* ss;
    __device__ __forceinline__ void operator()(const f32x4 (&acc)[2][2][4][2], const Unit& u, int wr, int wc, int fr, int fq) const {
        const int row0 = u.pm * BM + wr * 64 + fr, col0 = u.pn * BM + wc * 32 + 4 * fq;
        f32x4 cur[4], nxt[4];
#define ER_LOAD(dst, g_) do { const size_t off_ = (size_t)(row0 + ((g_) >> 2) * HALF + ((g_) & 3) * 16) * ldc + col0; _Pragma("unroll") for (int q_ = 0; q_ < 4; ++q_) dst[q_] = *(const f32x4*)(base + off_ + (q_ >> 1) * HALF + (q_ & 1) * 16); } while (0)
        ER_LOAD(cur, 0);
        float sq[8];
#pragma unroll
        for (int g = 0; g < 8; ++g) {
            if (g + 1 < 8) ER_LOAD(nxt, g + 1);
            const int ai = g >> 2, m = g & 3; const size_t off = (size_t)(row0 + ai * HALF + m * 16) * ldc + col0;
            float s2 = 0.f;
#pragma unroll
            for (int q = 0; q < 4; ++q) { const f32x4 v = cur[q] + acc[ai][q >> 1][m][q & 1]; *(f32x4*)(out + off + (q >> 1) * HALF + (q & 1) * 16) = v;
                if (xb) { u32x2 w; w.x = cvt_pk_bf16(v[0], v[1]); w.y = cvt_pk_bf16(v[2], v[3]); *(u32x2*)(xb + off + (q >> 1) * HALF + (q & 1) * 16) = w; s2 += (v[0] * v[0] + v[1] * v[1]) + (v[2] * v[2] + v[3] * v[3]); } }
            sq[g] = s2;
#pragma unroll
            for (int q = 0; q < 4; ++q) cur[q] = nxt[q];
        }
#undef ER_LOAD
        if (ss) {
#pragma unroll
            for (int g = 0; g < 8; ++g) { float t = sq[g]; t += __shfl_xor(t, 16); t += __shfl_xor(t, 32);
                if (fq == 0) atomicAdd(ss + row0 + (g >> 2) * HALF + (g & 3) * 16, t); }
        }
    }
};

template <int CTRL> __device__ __forceinline__ f32x4 dpp4(const f32x4 v) { f32x4 r;
    r[0] = __builtin_bit_cast(float, __builtin_amdgcn_update_dpp(0, __builtin_bit_cast(int, v[0]), CTRL, 0xf, 0xf, false)); r[1] = __builtin_bit_cast(float, __builtin_amdgcn_update_dpp(0, __builtin_bit_cast(int, v[1]), CTRL, 0xf, 0xf, false));
    r[2] = __builtin_bit_cast(float, __builtin_amdgcn_update_dpp(0, __builtin_bit_cast(int, v[2]), CTRL, 0xf, 0xf, false)); r[3] = __builtin_bit_cast(float, __builtin_amdgcn_update_dpp(0, __builtin_bit_cast(int, v[3]), CTRL, 0xf, 0xf, false)); return r; }
__device__ __forceinline__ f32x4 shf4(const f32x4 v, const int src) { f32x4 r; r[0] = __shfl(v[0], src); r[1] = __shfl(v[1], src); r[2] = __shfl(v[2], src); r[3] = __shfl(v[3], src); return r; }
struct EpiConvAct {
    static constexpr bool PERM = true, AFTER_DRAIN = false;
    bf16_t* ACT; const float* rs; const float* cw; const float* cb; float* HF; float* HL;
    __device__ __forceinline__ void operator()(const f32x4 (&acc)[2][2][4][2], const Unit& u, int wr, int wc, int fr, int fq) const {
        constexpr int NUPc = 22016, DFFc = 11008;
        const int row0 = u.pm * BM + wr * 64 + fr, ch0 = u.pn * 128 + wc * 32 + 8 * fq;
        const int l1 = fq * 16 + ((fr + 15) & 15), l2 = fq * 16 + ((fr + 14) & 15);
        float sc[2][4];
#pragma unroll
        for (int ai = 0; ai < 2; ++ai)
#pragma unroll
            for (int m = 0; m < 4; ++m) sc[ai][m] = 1.0f / __builtin_sqrtf(rs[row0 + ai * HALF + m * 16] * (1.0f / 4096.0f) + 1e-6f);
#pragma unroll
        for (int n = 0; n < 2; ++n) {
            const int ch = ch0 + 4 * n;
            const f32x4 wg0 = *(const f32x4*)(cw + ch), wg1 = *(const f32x4*)(cw + NUPc + ch), wg2 = *(const f32x4*)(cw + 2 * NUPc + ch), bg = *(const f32x4*)(cb + ch);
            const f32x4 wu0 = *(const f32x4*)(cw + DFFc + ch), wu1 = *(const f32x4*)(cw + NUPc + DFFc + ch), wu2 = *(const f32x4*)(cw + 2 * NUPc + DFFc + ch), bu = *(const f32x4*)(cb + DFFc + ch);
#pragma unroll
            for (int ai = 0; ai < 2; ++ai) {
                const int blk = u.pm * 4 + ai * 2 + wr;
                f32x4 q1g = (f32x4){0.f, 0.f, 0.f, 0.f}, q2g = q1g, q1u = q1g, q2u = q1g;
#pragma unroll
                for (int m = 0; m < 4; ++m) {
                    const int row = row0 + ai * HALF + m * 16;
                    const f32x4 xg = acc[ai][0][m][n] * sc[ai][m], xu = acc[ai][1][m][n] * sc[ai][m];
                    #ifdef CONV_DPP
                    const f32x4 p1g = dpp4<0x121>(xg), p2g = dpp4<0x122>(xg), p1u = dpp4<0x121>(xu), p2u = dpp4<0x122>(xu);
#else
                    const f32x4 p1g = shf4(xg, l1), p2g = shf4(xg, l2), p1u = shf4(xu, l1), p2u = shf4(xu, l2);
#endif
                    const f32x4 g1 = (fr == 0) ? q1g : p1g, g2 = (fr < 2) ? q2g : p2g, u1 = (fr == 0) ? q1u : p1u, u2 = (fr < 2) ? q2u : p2u;
                    const f32x4 gc = wg0 * g2 + wg1 * g1 + wg2 * xg + bg, uc = wu0 * u2 + wu1 * u1 + wu2 * xu + bu;
                    f32x4 a;
#pragma unroll
                    for (int j = 0; j < 4; ++j) a[j] = gc[j] * fsigmoid(gc[j]) * uc[j];
                    if (m > 0 || fr >= 2) { u32x2 w; w.x = cvt_pk_bf16(a[0], a[1]); w.y = cvt_pk_bf16(a[2], a[3]); *(u32x2*)(ACT + (size_t)row * DFFc + ch) = w; }
                    if (m == 0 && fr < 2) { float* h = HF + ((size_t)(blk * 2 + fr)) * NUPc; *(f32x4*)(h + ch) = xg; *(f32x4*)(h + DFFc + ch) = xu; }
                    if (m == 3 && fr >= 14) { float* h = HL + ((size_t)(blk * 2 + (fr - 14))) * NUPc; *(f32x4*)(h + ch) = xg; *(f32x4*)(h + DFFc + ch) = xu; }
                    q1g = p1g; q2g = p2g; q1u = p1u; q2u = p2u;
                }
            }
        }
    }
};
template <class Inner, long PART_BEHIND_ACT> struct EpiTail {
    static constexpr bool PERM = Inner::PERM, AFTER_DRAIN = false;
    Inner in;
    __device__ __forceinline__ void operator()(const f32x4 (&acc)[2][2][4][2], const Unit& u, int wr, int wc, int fr_, int fq_) const {
        int l_; asm volatile("v_mbcnt_lo_u32_b32 %0, -1, 0\n\tv_mbcnt_hi_u32_b32 %0, -1, %0" : "=v"(l_)); const int fr = l_ & 15, fq = l_ >> 4; (void)fr_; (void)fq_;
        if (u.seg == 0) { in(acc, u, wr, wc, fr, fq); return; }
        const int half = (int)(gridDim.x >> 1), cmod = (int)blockIdx.x % half;
        f32x4* dst = (f32x4*)((char*)in.ACT - PART_BEHIND_ACT) + ((size_t)((u.seg - 1) * half + cmod) * 512 + ((wr * 4 + wc) * 64 + fq * 16 + fr)) * 32;
#pragma unroll
        for (int ai = 0; ai < 2; ++ai)
#pragma unroll
            for (int bj = 0; bj < 2; ++bj)
#pragma unroll
                for (int m = 0; m < 4; ++m)
#pragma unroll
                    for (int n = 0; n < 2; ++n) dst[((ai * 2 + bj) * 4 + m) * 2 + n] = acc[ai][bj][m][n];
    }
};
template <class Epi, class Sched, bool ALIGN_EPI = false, bool SP2 = false>
__device__ __forceinline__ void gemm_phase(PG8_LAS unsigned char* lds, const Gemm g, const Sched& S, const Epi& E, const int wave_id) {
    int lane__; asm volatile("v_mbcnt_lo_u32_b32 %0, -1, 0\n\tv_mbcnt_hi_u32_b32 %0, -1, %0" : "=v"(lane__)); const int tid_ = wave_id * 64 + lane__;
    const int tid = tid_, wid = __builtin_amdgcn_readfirstlane(tid >> 6), lane = tid & 63, wr = wid >> 2, wc = wid & 3, fr = lane & 15, fq = lane >> 4;
    int K_ = g.K; asm volatile("" : "+s"(K_));
    const int K = K_, nt = K / BK;
    unsigned voffA[2], voffB[2];
#pragma unroll
    for (int i = 0; i < 2; ++i) { int R, C; stage_rc(tid * 16 + i * 8192, R, C); const int Rb = Epi::PERM ? ((R & ~31) + perm32(R & 31)) : R;
        voffA[i] = (unsigned)(R * K + C) * 2u; voffB[i] = (unsigned)(Rb * K + C) * 2u; }
    const size_t kstep = (size_t)(BK * 2);
    const size_t hstep = (size_t)HALF * K * 2;
    const size_t tstep = 2 * hstep;
    const unsigned ldsw = (unsigned)wid * 1024u;
    const int aoff = lds_byte(wr * 64 + fr, fq * 8), boff = lds_byte(wc * 32 + fr, fq * 8);
#define PG8_SA(b, h) (((b) * 2 + (h)) * HTB)
#define PG8_SB(b, h) ((4 + (b) * 2 + (h)) * HTB)
#define PG8_STAGE(bufoff, gbase, voff) do { _Pragma("unroll") for (int _i = 0; _i < 2; ++_i) \
        __builtin_amdgcn_global_load_lds((const unsigned*)((const char*)(gbase) + (voff)[_i]), (PG8_LAS unsigned*)(lds + (bufoff) + ldsw + _i * 8192), 16, 0, 0); } while (0)
#define PG8_LDA(dst, b, h) do { _Pragma("unroll") for (int m = 0; m < 4; ++m) _Pragma("unroll") for (int k = 0; k < 2; ++k) dst[m][k] = *(const PG8_LAS bf16x8*)(lds + PG8_SA(b, h) + aoff + m * 2048 + k * 1024); } while (0)
#define PG8_LDB(dst, b, h) do { _Pragma("unroll") for (int n = 0; n < 2; ++n) _Pragma("unroll") for (int k = 0; k < 2; ++k) dst[n][k] = *(const PG8_LAS bf16x8*)(lds + PG8_SB(b, h) + boff + n * 2048 + k * 1024); } while (0)
#define PG8_MMA(ai, bj, At, Bt) do { __builtin_amdgcn_s_setprio(1); _Pragma("unroll") for (int m = 0; m < 4; ++m) _Pragma("unroll") for (int n = 0; n < 2; ++n) _Pragma("unroll") for (int k = 0; k < 2; ++k) \
        acc[ai][bj][m][n] = __builtin_amdgcn_mfma_f32_16x16x32_bf16(Bt[n][k], At[m][k], acc[ai][bj][m][n], 0, 0, 0); __builtin_amdgcn_s_setprio(0); } while (0)
#define PG8_WAIT_V(n) asm volatile("s_waitcnt vmcnt(" #n ")" ::: "memory")
#define PG8_WAIT_L(n) asm volatile("s_waitcnt lgkmcnt(" #n ")" ::: "memory")
#define PG8_BAR __builtin_amdgcn_s_barrier()
#define PG8_SCHED __builtin_amdgcn_sched_barrier(0)
    Unit cur, nxt; int ui = 0;
    if (!S.next(0, cur)) return;
    f32x4 acc[2][2][4][2];
#pragma unroll
    for (int a = 0; a < 2; ++a)
#pragma unroll
        for (int b = 0; b < 2; ++b)
#pragma unroll
            for (int m = 0; m < 4; ++m)
#pragma unroll
                for (int n = 0; n < 2; ++n) acc[a][b][m][n] = (f32x4){0.f, 0.f, 0.f, 0.f};
    bf16x8 At[4][2], B0[2][2], B1[2][2];
    const char* cA = (const char*)S.a_base(g, cur) + (size_t)cur.pm * tstep; const char* cB = (const char*)S.b_base(g, cur) + (size_t)cur.pn * tstep;
    S.a_ready(cur);
    if constexpr (SP2) {
        PG8_STAGE(PG8_SB(0, 0), cB, voffB); PG8_STAGE(PG8_SB(0, 1), cB + hstep, voffB); PG8_STAGE(PG8_SA(0, 0), cA, voffA); PG8_STAGE(PG8_SA(0, 1), cA + hstep, voffA);
        if (wr == 1) PG8_BAR;
        PG8_WAIT_V(2); PG8_BAR;
        PG8_STAGE(PG8_SB(1, 0), cB + kstep, voffB); PG8_STAGE(PG8_SA(1, 0), cA + kstep, voffA); PG8_STAGE(PG8_SB(1, 1), cB + hstep + kstep, voffB);
        PG8_WAIT_V(6); PG8_BAR;
    } else {
        PG8_STAGE(PG8_SB(0, 0), cB, voffB); PG8_STAGE(PG8_SA(0, 0), cA, voffA); PG8_STAGE(PG8_SB(0, 1), cB + hstep, voffB); PG8_STAGE(PG8_SA(0, 1), cA + hstep, voffA);
        if (wr == 1) PG8_BAR;
        PG8_WAIT_V(4); PG8_BAR;
        PG8_STAGE(PG8_SB(1, 0), cB + kstep, voffB); PG8_STAGE(PG8_SA(1, 0), cA + kstep, voffA); PG8_STAGE(PG8_SB(1, 1), cB + hstep + kstep, voffB);
        PG8_WAIT_V(6); PG8_BAR;
    }
    for (;;) {
        const bool has_next = S.next(ui + 1, nxt);
        const char* nA = has_next ? (const char*)S.a_base(g, nxt) + (size_t)nxt.pm * tstep : cA; const char* nB = has_next ? (const char*)S.b_base(g, nxt) + (size_t)nxt.pn * tstep : cB;
        const int ntu = S.ntiles(cur, nt);
        for (int t = 0; t < ntu; t += 2) {
            const bool last = (t == ntu - 2);
            const char* a1 = cA + (size_t)(t + 1) * kstep;
            const char* a2 = last ? nA : cA + (size_t)(t + 2) * kstep; const char* b2 = last ? nB : cB + (size_t)(t + 2) * kstep;
            const char* a3 = a2 + kstep; const char* b3 = b2 + kstep;
            if (last && has_next) S.a_ready(nxt);
            if constexpr (SP2) {
            PG8_LDB(B0, 0, 0); PG8_LDB(B1, 0, 1); PG8_SCHED; PG8_LDA(At, 0, 0); PG8_STAGE(PG8_SA(1, 1), a1 + hstep, voffA);
            PG8_WAIT_V(8); PG8_WAIT_L(0); PG8_BAR; PG8_MMA(0, 0, At, B0); PG8_MMA(0, 1, At, B1); PG8_BAR; PG8_SCHED;
            PG8_LDA(At, 0, 1); PG8_STAGE(PG8_SB(0, 0), b2, voffB); PG8_STAGE(PG8_SB(0, 1), b2 + hstep, voffB); PG8_STAGE(PG8_SA(0, 0), a2, voffA);
            PG8_WAIT_V(8); PG8_WAIT_L(0); PG8_BAR; PG8_MMA(1, 0, At, B0); PG8_MMA(1, 1, At, B1); PG8_BAR; PG8_SCHED;
            PG8_LDB(B0, 1, 0); PG8_LDB(B1, 1, 1); PG8_SCHED; PG8_LDA(At, 1, 0); PG8_STAGE(PG8_SA(0, 1), a2 + hstep, voffA);
            PG8_WAIT_V(8); PG8_WAIT_L(0); PG8_BAR; PG8_MMA(0, 0, At, B0); PG8_MMA(0, 1, At, B1); PG8_BAR; PG8_SCHED;
            PG8_LDA(At, 1, 1); PG8_STAGE(PG8_SB(1, 0), b3, voffB); PG8_STAGE(PG8_SB(1, 1), b3 + hstep, voffB); PG8_STAGE(PG8_SA(1, 0), a3, voffA);
            PG8_WAIT_V(8); PG8_WAIT_L(0); PG8_BAR; PG8_MMA(1, 0, At, B0); PG8_MMA(1, 1, At, B1); PG8_BAR; PG8_SCHED;
            } else {
            PG8_LDB(B0, 0, 0); PG8_SCHED; PG8_LDA(At, 0, 0); PG8_STAGE(PG8_SA(1, 1), a1 + hstep, voffA);
            PG8_WAIT_L(8); PG8_BAR; PG8_WAIT_L(0); PG8_MMA(0, 0, At, B0); PG8_BAR; PG8_SCHED;
            PG8_LDB(B1, 0, 1); PG8_STAGE(PG8_SB(0, 0), b2, voffB);
            PG8_BAR; PG8_WAIT_L(0); PG8_MMA(0, 1, At, B1); PG8_BAR;
            PG8_LDA(At, 0, 1); PG8_STAGE(PG8_SA(0, 0), a2, voffA);
            PG8_BAR; PG8_WAIT_L(0); PG8_MMA(1, 0, At, B0); PG8_BAR; PG8_SCHED;
            PG8_STAGE(PG8_SB(0, 1), b2 + hstep, voffB);
            PG8_WAIT_V(6); PG8_BAR; PG8_MMA(1, 1, At, B1); PG8_BAR;
            PG8_LDB(B0, 1, 0); PG8_SCHED; PG8_LDA(At, 1, 0); PG8_STAGE(PG8_SA(0, 1), a2 + hstep, voffA);
            PG8_WAIT_L(8); PG8_BAR; PG8_WAIT_L(0); PG8_MMA(0, 0, At, B0); PG8_BAR; PG8_SCHED;
            PG8_LDB(B1, 1, 1); PG8_STAGE(PG8_SB(1, 0), b3, voffB);
            PG8_BAR; PG8_WAIT_L(0); PG8_MMA(0, 1, At, B1); PG8_BAR;
            PG8_LDA(At, 1, 1); PG8_STAGE(PG8_SA(1, 0), a3, voffA);
            PG8_BAR; PG8_WAIT_L(0); PG8_MMA(1, 0, At, B0); PG8_BAR; PG8_SCHED;
            PG8_STAGE(PG8_SB(1, 1), b3 + hstep, voffB);
            PG8_WAIT_V(6); PG8_BAR; PG8_MMA(1, 1, At, B1); PG8_BAR;
            }
        }
        if constexpr (ALIGN_EPI) { if (wr == 0) PG8_BAR; }
        if constexpr (!Epi::AFTER_DRAIN) { E(acc, cur, wr, wc, fr, fq); S.done(cur); }
        if (!has_next) break;
        if (!S.keep(cur)) {
#pragma unroll
        for (int a = 0; a < 2; ++a)
#pragma unroll
            for (int b = 0; b < 2; ++b)
#pragma unroll
                for (int m = 0; m < 4; ++m)
#pragma unroll
                    for (int n = 0; n < 2; ++n) acc[a][b][m][n] = (f32x4){0.f, 0.f, 0.f, 0.f};
        }
        cur = nxt; cA = nA; cB = nB; ++ui;
        if constexpr (ALIGN_EPI) { if (wr == 1) PG8_BAR; }
    }
    PG8_WAIT_V(0);
    if constexpr (!ALIGN_EPI) { if (wr == 0) PG8_BAR; }
    PG8_BAR;
    if constexpr (Epi::AFTER_DRAIN) { E.fused(acc, cur, wr, wc, fr, fq, lds, wid, lane); S.done(cur); }
#undef PG8_SA
#undef PG8_SB
#undef PG8_STAGE
#undef PG8_LDA
#undef PG8_LDB
#undef PG8_MMA
#undef PG8_WAIT_V
#undef PG8_WAIT_L
#undef PG8_BAR
#undef PG8_SCHED
}
}
constexpr int NB = 4, SEQ = 4096, DM = 4096, M = NB * SEQ;
constexpr int DFF = 11008, NUP = 2 * DFF;
constexpr int IN_COLS = 23920;
constexpr int NA1 = 12032, NGT = 12288, NWIN = NA1 + NGT;
constexpr int LDPA = 4096, LDPB = 3584, LDPC = 4352;
constexpr int NLORA = 3072, KLORA = 384;
constexpr float NORM_EPS = 1e-6f;
constexpr int NWAVES = 8;
constexpr size_t MiB = 1u << 20;
constexpr size_t WS_CTL = 0, CTL_ZERO_BYTES = 1 * MiB;
constexpr size_t WS_WIN = 1 * MiB;
constexpr size_t WS_WA = WS_WIN + (size_t)NWIN * DM * 2;
constexpr size_t WS_WB = WS_WA + (size_t)DM * 2048 * 2;
constexpr size_t WS_WC = WS_WB + (size_t)DM * 2048 * 2;
constexpr size_t WS_WOUT = WS_WC + (size_t)DM * 2048 * 2;
constexpr size_t WS_WUP = WS_WOUT + (size_t)DM * DM * 2;
constexpr size_t WS_WDN = WS_WUP + (size_t)NUP * DM * 2;
constexpr size_t WS_WLORA = WS_WDN + (size_t)DM * DFF * 2;
constexpr size_t WS_XB = WS_WLORA + (size_t)NLORA * KLORA * 2;
constexpr size_t WS_RS = WS_XB + (size_t)M * DM * 2;
constexpr size_t WS_ROPE = WS_RS + (size_t)M * 4;
constexpr size_t WS_R1 = WS_ROPE + (size_t)M * 48 * 4;
constexpr size_t WS_G = WS_R1;
constexpr size_t WS_PA = WS_G + (size_t)M * NGT * 2;
constexpr size_t WS_PAF = WS_PA + (size_t)M * LDPA * 2;
constexpr size_t WS_PB = WS_PA + (size_t)M * LDPA * 4;
constexpr size_t WS_PC = WS_PB + (size_t)M * LDPB * 4;
constexpr size_t WS_R1_END = WS_PC + (size_t)M * LDPC * 4;
constexpr size_t WS_SCANIN = WS_PB;
constexpr size_t WS_MG = WS_PB;
constexpr size_t WS_MERGED = WS_MG + (size_t)M * DM * 4;
constexpr size_t WS_U = WS_R1;
constexpr size_t WS_HALOF = WS_R1;
constexpr size_t WS_HALOL = WS_HALOF + (size_t)256 * 2 * NUP * 4;
constexpr size_t WS_ACT = WS_U + (size_t)M * NUP * 2;
constexpr size_t WS_PART = WS_R1 + 128 * MiB;
static_assert(WS_HALOL + (size_t)256 * 2 * NUP * 4 <= WS_PART && WS_PART + 64 * MiB <= WS_ACT, "tail partials");
static_assert(WS_SCANIN + (size_t)64 * 4096 * 320 * 4 <= WS_R1_END && WS_MERGED + (size_t)M * DM * 2 <= WS_R1_END && WS_ACT + (size_t)M * DFF * 2 <= WS_R1_END, "R1 overlays");
constexpr size_t WS_LA = WS_R1_END;
constexpr size_t WS_LO = WS_LA + (size_t)M * KLORA * 2;
constexpr size_t WS_RKV = WS_LO + (size_t)M * NLORA * 4;
constexpr size_t WS_SC = WS_RKV + (size_t)M * 3072 * 4;
constexpr size_t WS_MASK = WS_SC + (size_t)NB * SEQ * SEQ * 4;
constexpr size_t WS_QC = WS_MASK + (size_t)M * 64 * 8;
constexpr size_t WS_KC = WS_QC + (size_t)M * 2048 * 2;
constexpr size_t WS_VT = WS_KC + (size_t)M * 512 * 2;
constexpr size_t WS_QI = WS_VT + (size_t)M * 512 * 2;
constexpr size_t WS_KI = WS_QI + (size_t)M * 1024 * 2;
constexpr size_t WS_WI = WS_KI + (size_t)M * 64 * 2;
constexpr size_t WS_RK = WS_WI + (size_t)M * 16 * 4;
constexpr size_t WS_C23 = WS_RK + (size_t)M * 16 * 4;
constexpr size_t WS_OAR = WS_C23 + (size_t)M * 16 * 2 * 4;
constexpr size_t WS_OBR = WS_OAR + (size_t)M * 1024 * 4;
constexpr size_t WS_OA = WS_OBR + (size_t)M * 1024 * 4;
constexpr size_t WS_OB = WS_OA + (size_t)M * 2048 * 2;
constexpr size_t WS_OC = WS_OB + (size_t)M * 2048 * 2;
constexpr size_t WS_END = WS_OC + (size_t)M * 2048 * 2;
static_assert(WS_END <= (size_t)3135242240ull, "workspace map exceeds 4x the largest input");
constexpr size_t CTL_SSQ = 256 * 1024;
constexpr int CW_TMO = 0, CW_CODE = 1, CW_BAR = 4096, CW_QUEUE = 8192;
constexpr int RING_OFF = 0, RING_BYTES = 131072;
constexpr int LDSCTL_OFF = RING_BYTES, MISC_OFF = LDSCTL_OFF + 320;
constexpr int LDS_BYTES = 147456;
#define GAS __attribute__((address_space(1)))
#define LAS __attribute__((address_space(3)))
typedef unsigned short bf16;
typedef unsigned v4u __attribute__((ext_vector_type(4)));
typedef float f32x4 __attribute__((ext_vector_type(4)));
typedef short bf16x8 __attribute__((ext_vector_type(8)));
typedef GAS unsigned gu32;
typedef GAS unsigned long long gu64;
#define RLX_AGENT __ATOMIC_RELAXED, __HIP_MEMORY_SCOPE_AGENT
#define LDS_WAIT() asm volatile("s_waitcnt lgkmcnt(0)" ::: "memory")
#define VM_WAIT() asm volatile("s_waitcnt vmcnt(0)" ::: "memory")
__device__ __forceinline__ unsigned long long rt() { return __builtin_amdgcn_s_memrealtime(); }
__device__ __forceinline__ unsigned f2bf(float f) { unsigned u = __builtin_bit_cast(unsigned, f); return (u + 0x7fffu + ((u >> 16) & 1u)) >> 16; }
__device__ __forceinline__ unsigned pk2(float lo, float hi) { return f2bf(lo) | (f2bf(hi) << 16); }

#define XB_TMO      128
#define XB_XCNT(j)  (256  + 64 * (j))
#define XB_XSUB(j)  (1280 + 64 * (j))
#define XB_XGEN(j)  (2304 + 64 * (j))
#define XB_TOP      3328
#define XB_TOPGEN   3392
#define XCD_BAR_WORDS 3456
#define XB_SPIN_CAP (1u << 18)

__device__ __forceinline__ unsigned xb_ld(unsigned* p)              { return __hip_atomic_load(p, __ATOMIC_RELAXED, __HIP_MEMORY_SCOPE_AGENT); }
__device__ __forceinline__ unsigned xb_add(unsigned* p, unsigned v) { return __hip_atomic_fetch_add(p, v, __ATOMIC_RELAXED, __HIP_MEMORY_SCOPE_AGENT); }
__device__ __forceinline__ unsigned xb_xcc_id() { return (unsigned)__builtin_amdgcn_s_getreg((3 << 11) | 20) & 0xFu; }
#define XB_SPIN(cond, bar) do { unsigned _sp = 0; while (cond) { __builtin_amdgcn_s_sleep(1); \
    if ((++_sp & 255u) == 0u) { if (xb_ld(&(bar)[XB_TMO])) break; if (_sp > XB_SPIN_CAP) { atomicAdd(&(bar)[XB_TMO], 1u); break; } } } } while (0)

struct XcdBarrier {
    unsigned* bar; unsigned x;
    volatile LAS unsigned* st;
};

__device__ __forceinline__ XcdBarrier xcd_barrier_post(unsigned* bar, volatile LAS unsigned* st) {
    XcdBarrier b; b.bar = bar; b.x = xb_xcc_id(); b.st = st;
    if (threadIdx.x == 0) (void)xb_add(&bar[XB_XCNT(b.x)], 1u);
    return b;
}
__device__ __forceinline__ void xcd_barrier_complete(unsigned* bar, unsigned x, unsigned& nloc, unsigned& nx) {
    const unsigned G = gridDim.x * gridDim.y * gridDim.z;
    unsigned sum, cnt, mine, sp = 0u;
    for (;;) {
        sum = 0u; cnt = 0u; mine = 0u;
#pragma unroll
        for (unsigned j = 0; j < 16; ++j) { const unsigned c = xb_ld(&bar[XB_XCNT(j)]); sum += c; cnt += (c > 0u) ? 1u : 0u; mine = (j == x) ? c : mine; }
        if (sum == G) break;
        __builtin_amdgcn_s_sleep(1);
        if ((++sp & 255u) == 0u) { if (xb_ld(&bar[XB_TMO])) break; if (sp > XB_SPIN_CAP) { atomicAdd(&bar[XB_TMO], 1u); break; } }
    }
    nloc = mine > 0u ? mine : 1u; nx = cnt > 0u ? cnt : 1u;
}

__device__ __forceinline__ void xcd_barrier(const XcdBarrier& b) {
    asm volatile("s_waitcnt vmcnt(0)" ::: "memory");
    __syncthreads();
    if (threadIdx.x == 0) {
        unsigned* bar = b.bar;
        __builtin_amdgcn_s_waitcnt(0);
        unsigned nloc = b.st[0], nx = b.st[1];
        if (nloc == 0u) { xcd_barrier_complete(bar, b.x, nloc, nx); b.st[0] = nloc; b.st[1] = nx; }
        const unsigned old = xb_add(&bar[XB_XSUB(b.x)], 1u);
        const unsigned gen = old / nloc;
        if (old + 1u == (gen + 1u) * nloc) {
            __builtin_amdgcn_fence(__ATOMIC_RELEASE, "agent");
            asm volatile("s_waitcnt vmcnt(0)" ::: "memory");
            const unsigned og = xb_add(&bar[XB_TOP], 1u);
            const unsigned tg = og / nx;
            if (og + 1u == (tg + 1u) * nx) xb_add(&bar[XB_TOPGEN], 1u);
            else XB_SPIN(xb_ld(&bar[XB_TOPGEN]) == tg, bar);
            __builtin_amdgcn_fence(__ATOMIC_ACQUIRE, "agent");
            xb_add(&bar[XB_XGEN(b.x)], 1u);
            asm volatile("s_waitcnt vmcnt(0)" ::: "memory");
        } else {
            XB_SPIN(xb_ld(&bar[XB_XGEN(b.x)]) == gen, bar);
            __builtin_amdgcn_fence(__ATOMIC_ACQUIRE, "agent");
            asm volatile("s_waitcnt vmcnt(0)" ::: "memory");
        }
    }
    __syncthreads();
}

typedef unsigned u32x2v __attribute__((ext_vector_type(2)));
typedef unsigned long long u64;
typedef float f32x2v __attribute__((ext_vector_type(2)));
struct Frame {
    LAS unsigned char* lds;
    volatile LAS unsigned* MISC;
    gu32* ctl;
    int tid, lane, wave, G;
    unsigned char* ws;
    const void* const* in;
};
#define OPAQUE_IDS() int wave_ = F.wave; asm volatile("" : "+s"(wave_)); const int wave = wave_; int lane_; asm volatile("v_mbcnt_lo_u32_b32 %0, -1, 0\n\tv_mbcnt_hi_u32_b32 %0, -1, %0" : "=v"(lane_)); const int lane = lane_; const int tid = wave * 64 + lane; (void)lane; (void)wave; (void)tid; size_t wz_ = 0; asm volatile("" : "+s"(wz_)); unsigned char* wsb = F.ws + wz_;     int bid_ = blockIdx.x; asm volatile("" : "+s"(bid_)); const int bid = bid_; int G_ = F.G; asm volatile("" : "+s"(G_)); const int G = G_; (void)bid; (void)G
__device__ __forceinline__ float wave_sum(float v) {
#pragma unroll
    for (int o = 1; o < 64; o <<= 1) v += __shfl_xor(v, o);
    return v;
}
__device__ __forceinline__ float bf2f(unsigned short h) { return __uint_as_float(((unsigned)h) << 16); }
__device__ __forceinline__ unsigned pkbf(float lo, float hi) { return pg8::cvt_pk_bf16(lo, hi); }
__device__ __forceinline__ f32x4 bf4_to_f32(u32x2v w) { f32x4 r; r.x = __uint_as_float(w.x << 16); r.y = __uint_as_float(w.x & 0xffff0000u); r.z = __uint_as_float(w.y << 16); r.w = __uint_as_float(w.y & 0xffff0000u); return r; }
__device__ __forceinline__ float fsig(float x) { return 1.0f / (1.0f + __expf(-x)); }
__device__ __forceinline__ float vfma(float a, float b, float c) { float d; asm("v_fma_f32 %0, %1, %2, %3" : "=v"(d) : "v"(a), "v"(b), "v"(c)); return d; }
__device__ __forceinline__ float xsum32(float v) { const unsigned u = __float_as_uint(v); const auto r = __builtin_amdgcn_permlane32_swap(u, u, false, false); return __uint_as_float(r[0]) + __uint_as_float(r[1]); }
__device__ __forceinline__ float xsum16(float v) { const unsigned u = __float_as_uint(v); const auto r = __builtin_amdgcn_permlane16_swap(u, u, false, false); return __uint_as_float(r[0]) + __uint_as_float(r[1]); }
__device__ __forceinline__ float vmul(float a, float b) { float d; asm("v_mul_f32 %0, %1, %2" : "=v"(d) : "v"(a), "v"(b)); return d; }
__device__ __forceinline__ float vfnma(float a, float b, float c) { float d; asm("v_fma_f32 %0, -%1, %2, %3" : "=v"(d) : "v"(a), "v"(b), "v"(c)); return d; }
template <int CTRL> __device__ __forceinline__ float dppf(float v) { return __builtin_bit_cast(float, __builtin_amdgcn_update_dpp(0, __builtin_bit_cast(int, v), CTRL, 0xf, 0xf, false)); }
__device__ __forceinline__ float sum16(float v) { v += dppf<0xB1>(v); v += dppf<0x4E>(v); v += dppf<0x124>(v); v += dppf<0x128>(v); return v; }

template <int MAP> __device__ __forceinline__ int wcol_map(int n) {
    if (MAP == 0) return n;
    if (MAP == 2) { const int tile = n >> 8, r = n & 255; return (r < 128) ? tile * 128 + r : DFF + tile * 128 + (r - 128); }
    if (n < 7456) return n; if (n < 7680) return -1; if (n < 11856) return n - 224; if (n < 12032) return -1; return n - 400;
}
template <int MAP> __device__ __forceinline__ void conv_item(const float* W, int K, int ldw, const float* gain, bf16* WT, LAS float* scr, int item, int nblk, int lane, int ldt = 0) {
    if (ldt == 0) ldt = K;
    const int kb = item / nblk, nb = item % nblk, k0 = 64 * kb, n0 = 32 * nb;
    const int src = wcol_map<MAP>(n0 + (lane & 31));
    float v[32];
    const float* wp = W + (size_t)(k0 + (lane >> 5)) * ldw + (src >= 0 ? src : 0);
#pragma unroll
#ifndef NT_W
#define NT_W 0
#endif
    for (int i = 0; i < 32; ++i) v[i] = (src >= 0) ? (NT_W ? __builtin_nontemporal_load(wp + (size_t)(2 * i) * ldw) : wp[(size_t)(2 * i) * ldw]) : 0.f;
    if (gain) {
#pragma unroll
        for (int i = 0; i < 32; ++i) v[i] *= gain[k0 + 2 * i + (lane >> 5)]; }
#pragma unroll
    for (int i = 0; i < 32; ++i) scr[(2 * i + (lane >> 5)) * 33 + (lane & 31)] = v[i];
    LDS_WAIT(); asm volatile("" ::: "memory");
    const int c = lane & 7;
#pragma unroll
    for (int j = 0; j < 4; ++j) { const int n = (lane >> 3) + 8 * j; const LAS float* s = scr + (8 * c) * 33 + n;
        v4u o; o.x = pkbf(s[0 * 33], s[1 * 33]); o.y = pkbf(s[2 * 33], s[3 * 33]); o.z = pkbf(s[4 * 33], s[5 * 33]); o.w = pkbf(s[6 * 33], s[7 * 33]);
        *(GAS v4u*)(WT + (size_t)(n0 + n) * ldt + k0 + 8 * c) = o; }
    LDS_WAIT(); asm volatile("" ::: "memory");
}
struct LayerIn {
    const float *norm_mix, *w_in, *lb0, *lb1, *out_norm, *mu, *w0, *w2, *a0, *a2, *g2, *k_k, *k_a, *r_k, *ln_w, *ln_b, *q_norm, *k_norm, *wba, *wbb, *wbc, *w_out, *norm_ffn, *w_up, *conv_w, *conv_b, *w_down;
};
__device__ __forceinline__ void phase_weights(Frame& F, const LayerIn& L) {
    OPAQUE_IDS();
    LAS float* scr = (LAS float*)(F.lds + RING_OFF + wave * 16384);
    const int gw = bid * NWAVES + wave, NGW = G * NWAVES;
    constexpr int I_IN = (DM / 64) * (NWIN / 32), I_A = (1024 / 64) * (DM / 32), I_C = (2048 / 64) * (DM / 32), I_O = (DM / 64) * (DM / 32), I_UP = (DM / 64) * (NUP / 32), I_DN = (DFF / 64) * (DM / 32);
    constexpr int NITEMS = I_IN + 2 * I_A + I_C + I_O + I_UP + I_DN;
    bf16* ws = (bf16*)wsb;
    for (int it = gw; it < NITEMS; it += NGW) {
        int r = it;
        if (r < I_IN) { conv_item<1>(L.w_in, DM, IN_COLS, L.norm_mix, (bf16*)(wsb + WS_WIN), scr, r, NWIN / 32, lane); continue; } r -= I_IN;
        if (r < I_A) { conv_item<0>(L.wba, 1024, DM, nullptr, (bf16*)(wsb + WS_WA), scr, r, DM / 32, lane, 2048); continue; } r -= I_A;
        if (r < I_A) { conv_item<0>(L.wbb, 1024, DM, nullptr, (bf16*)(wsb + WS_WB), scr, r, DM / 32, lane, 2048); continue; } r -= I_A;
        if (r < I_C) { conv_item<0>(L.wbc, 2048, DM, nullptr, (bf16*)(wsb + WS_WC), scr, r, DM / 32, lane); continue; } r -= I_C;
        if (r < I_O) { conv_item<0>(L.w_out, DM, DM, nullptr, (bf16*)(wsb + WS_WOUT), scr, r, DM / 32, lane); continue; } r -= I_O;
        if (r < I_UP) { conv_item<2>(L.w_up, DM, NUP, L.norm_ffn, (bf16*)(wsb + WS_WUP), scr, r, NUP / 32, lane); continue; } r -= I_UP;
        conv_item<0>(L.w_down, DFF, DM, nullptr, (bf16*)(wsb + WS_WDN), scr, r, DM / 32, lane);
    }
    (void)ws;
    bf16* WL = (bf16*)(wsb + WS_WLORA);
    for (int e = bid * 512 + tid; e < NLORA * KLORA; e += G * 512) {
        const int n = e / KLORA, k = e % KLORA, seg = n >> 10, col = n & 1023; float v = 0.f;
        if (seg == 0) { if (k < 64) v = L.w2[(size_t)k * 1024 + col]; }
        else if (seg == 1) { if (k >= 64 && k < 128) v = L.a2[(size_t)(k - 64) * 1024 + col]; }
        else { if (k >= 128 && k < 288) v = L.g2[(size_t)(k - 128) * 1024 + col]; }
        WL[e] = (bf16)(pkbf(v, 0.f) & 0xffffu);
    }
}
__device__ __forceinline__ void phase_norm(Frame& F, const float* x) {
    OPAQUE_IDS();
    const int gw = bid * NWAVES + wave, NGW = G * NWAVES;
    bf16* XB = (bf16*)(wsb + WS_XB); float* RS = (float*)(wsb + WS_RS);
    for (int m = gw; m < M; m += NGW) {
        const GAS f32x4* xr = (const GAS f32x4*)(x + (size_t)m * DM) + lane;
        GAS u64* o8 = (GAS u64*)(XB + (size_t)m * DM) + lane;
        float s = 0.f; f32x4 xv[16];
#pragma unroll
        for (int j = 0; j < 16; ++j) xv[j] = xr[64 * j];
#pragma unroll
        for (int j = 0; j < 16; ++j) { const f32x4 v = xv[j]; s += (v.x * v.x + v.y * v.y) + (v.z * v.z + v.w * v.w);
            o8[64 * j] = (u64)pkbf(v.x, v.y) | ((u64)pkbf(v.z, v.w) << 32); }
        s = wave_sum(s);
        if (lane == 0) RS[m] = s;
    }
}
__device__ __forceinline__ void sincos_acc(float angf, float& sn, float& cs) {
    const double x = (double)angf;
    const double q = rint(x * 0.63661977236758134308);
    const double y = (x - q * 1.57079632679489655800) - q * 6.123233995736766036e-17;
    const double y2 = y * y;
    const double sp = y * (1.0 + y2 * (-1.0 / 6 + y2 * (1.0 / 120 + y2 * (-1.0 / 5040 + y2 * (1.0 / 362880 + y2 * (-1.0 / 39916800 + y2 * (1.0 / 6227020800.0)))))));
    const double cp = 1.0 + y2 * (-0.5 + y2 * (1.0 / 24 + y2 * (-1.0 / 720 + y2 * (1.0 / 40320 + y2 * (-1.0 / 3628800 + y2 * (1.0 / 479001600 + y2 * (-1.0 / 87178291200.0)))))));
    const int qi = ((int)(long long)q) & 3;
    double s, c;
    if (qi == 0) { s = sp; c = cp; } else if (qi == 1) { s = cp; c = -sp; } else if (qi == 2) { s = -sp; c = -cp; } else { s = -cp; c = sp; }
    sn = (float)s; cs = (float)c;
}
__device__ __forceinline__ float rope_invf(int i) {
    switch (i) {
    case 0: return 1.000000000e+00f; case 1: return 4.403665960e-01f; case 2: return 1.939227432e-01f; case 3: return 8.539710194e-02f;
    case 4: return 3.760603070e-02f; case 5: return 1.656044088e-02f; case 6: return 7.292664610e-03f; case 7: return 3.211446106e-03f;
    case 8: return 1.414213562e-03f; case 9: return 6.227724371e-04f; case 10: return 2.742481884e-04f; case 11: return 1.207697351e-04f;
    case 12: return 5.318295734e-05f; case 13: return 2.341999971e-05f; case 14: return 1.031338525e-05f; case 15: return 4.541670478e-06f;
    case 16: return 1.000000000e+00f; case 17: return 1.939227432e-01f; case 18: return 3.760603070e-02f; case 19: return 7.292664610e-03f;
    case 20: return 1.414213562e-03f; case 21: return 2.742481884e-04f; case 22: return 5.318295734e-05f; default: return 1.031338525e-05f; }
}
__device__ __forceinline__ void phase_rope_tables(Frame& F, const int* positions) {
    OPAQUE_IDS();
    float* RT = (float*)(wsb + WS_ROPE);
    for (int e = bid * 512 + tid; e < M * 24; e += G * 512) {
        const int m = e / 24, i = e % 24; const float pos = (float)positions[m];
        const float ang = pos * rope_invf(i); float sn, cs; sincos_acc(ang, sn, cs);
        if (i < 16) { RT[(size_t)m * 48 + i] = cs; RT[(size_t)m * 48 + 16 + i] = sn; } else { RT[(size_t)m * 48 + 32 + (i - 16)] = cs; RT[(size_t)m * 48 + 40 + (i - 16)] = sn; }
    }
}
__device__ __forceinline__ void phase_prep(Frame& F, const LayerIn& L) {
    OPAQUE_IDS();
    const int gw = bid * NWAVES + wave, NGW = G * NWAVES;
    const bf16* PB = (const bf16*)(wsb + WS_PB); float* RKV = (float*)(wsb + WS_RKV); bf16* LA = (bf16*)(wsb + WS_LA);
#ifndef REPB1
#define REPB1 1
#endif
#ifndef REPB2
#define REPB2 1
#endif
    f32x4 muv[12];
#pragma unroll
    for (int it = 0; it < 12; ++it) muv[it] = *(const GAS f32x4*)(L.mu + (lane + 64 * it) * 4);
    const int c4x = 768 + lane;
    const f32x4 mux0 = *(const GAS f32x4*)(L.mu + c4x * 4), mux1 = *(const GAS f32x4*)(L.mu + (lane < 8 ? c4x + 64 : c4x) * 4);
    for (int rb1_ = 0; rb1_ < REPB1; ++rb1_)
    for (int m = gw; m < M; m += NGW) {
        const bool has_prev = (m % SEQ) != 0; const float hp = has_prev ? 1.0f : 0.0f;
        const bf16* cur = PB + (size_t)m * LDPB; const bf16* prv = has_prev ? cur - LDPB : cur;
        u32x2v rc[12], rp[12];
#pragma unroll
        for (int it = 0; it < 12; ++it) { const int c = (lane + 64 * it) * 4; rc[it] = *(const GAS u32x2v*)(cur + c); rp[it] = *(const GAS u32x2v*)(prv + c); }
        const u32x2v xc0 = *(const GAS u32x2v*)(cur + c4x * 4), xp0 = *(const GAS u32x2v*)(prv + c4x * 4);
        const u32x2v xc1 = *(const GAS u32x2v*)(cur + (lane < 8 ? c4x + 64 : c4x) * 4), xp1 = *(const GAS u32x2v*)(prv + (lane < 8 ? c4x + 64 : c4x) * 4);
#pragma unroll
        for (int it = 0; it < 12; ++it) {
            const int c = (lane + 64 * it) * 4;
            const f32x4 pc = bf4_to_f32(rc[it]), pp = bf4_to_f32(rp[it]) * hp;
            *(GAS f32x4*)(RKV + (size_t)m * 3072 + c) = pc + (pp - pc) * muv[it];
        }
#pragma unroll
        for (int it = 0; it < 2; ++it) {
            const int c4 = c4x + 64 * it;
            if (it == 0 || lane < 8) { const int c = c4 * 4;
                const f32x4 pc = bf4_to_f32(it == 0 ? xc0 : xc1), pp = bf4_to_f32(it == 0 ? xp0 : xp1) * hp;
                const f32x4 ps = pc + (pp - pc) * (it == 0 ? mux0 : mux1); f32x4 o = ps;
                if (c < 3136) { o.x = tanhf(ps.x); o.y = tanhf(ps.y); o.z = tanhf(ps.z); o.w = tanhf(ps.w); }
                else if (c >= 3200) { o.x = fsig(ps.x); o.y = fsig(ps.y); o.z = fsig(ps.z); o.w = fsig(ps.w); }
                *(GAS u64*)(LA + (size_t)m * KLORA + (c - 3072)) = (u64)pkbf(o.x, o.y) | ((u64)pkbf(o.z, o.w) << 32); }
        }
        if (lane < 24) { u64 z = 0ull; asm volatile("" : "+v"(z)); *(GAS u64*)(LA + (size_t)m * KLORA + 288 + lane * 4) = z; }
    }
    const bf16* PC = (const bf16*)(wsb + WS_PC); const float* RT = (const float*)(wsb + WS_ROPE);
    bf16* QC = (bf16*)(wsb + WS_QC); bf16* KC = (bf16*)(wsb + WS_KC); bf16* VT = (bf16*)(wsb + WS_VT); bf16* QI = (bf16*)(wsb + WS_QI); bf16* KI = (bf16*)(wsb + WS_KI); float* WI = (float*)(wsb + WS_WI);
    LAS bf16* VL = (LAS bf16*)(F.lds + RING_OFF);
    constexpr float QSCALE = 0.08838834764831845f * 1.4426950408889634f;
    for (int rb2_ = 0; rb2_ < REPB2; ++rb2_)
    for (int blk = bid; blk < M / 64; blk += G) {
        __syncthreads();
        for (int tt = 0; tt < 8; ++tt) {
            const int tl = wave * 8 + tt, m = blk * 64 + tl;
            const bf16* prow = PC + (size_t)m * LDPC; const float* rt = RT + (size_t)m * 48;
#pragma unroll
            for (int pass = 0; pass < 2; ++pass) {
                const bool act = (pass == 0) || (lane < 16);
                const bf16* src = prow + (pass == 0 ? 0 : 2048) + (pass == 0 ? lane : (lane & 15)) * 32;     const float* gain = (pass == 0 ? L.q_norm : L.k_norm) + (lane & 3) * 32;
                float y[32]; float ss = 0.f;
#pragma unroll
                for (int i = 0; i < 8; ++i) { const f32x4 v = bf4_to_f32(*(const GAS u32x2v*)(src + 4 * i)); y[4 * i] = v.x; y[4 * i + 1] = v.y; y[4 * i + 2] = v.z; y[4 * i + 3] = v.w; ss += (v.x * v.x + v.y * v.y) + (v.z * v.z + v.w * v.w); }
                ss += __shfl_xor(ss, 1); ss += __shfl_xor(ss, 2);
                const float rinv = 1.0f / sqrtf(ss * (1.0f / 128.0f) + NORM_EPS);
#pragma unroll
                for (int i = 0; i < 32; ++i) y[i] = y[i] * rinv * gain[i];
                if ((lane & 3) == 0) {
#pragma unroll
                    for (int i = 0; i < 16; ++i) { const float cs = rt[i], sn = rt[16 + i], a = y[i], b2 = y[i + 16]; y[i] = a * cs - b2 * sn; y[i + 16] = b2 * cs + a * sn; } }
                const float sc = (pass == 0) ? QSCALE : 1.0f;
                if (act) { bf16* dst = (pass == 0 ? QC + (size_t)m * 2048 : KC + (size_t)m * 512) + lane * 32;
#pragma unroll
                    for (int i = 0; i < 4; ++i) { v4u o; o.x = pkbf(y[8 * i] * sc, y[8 * i + 1] * sc); o.y = pkbf(y[8 * i + 2] * sc, y[8 * i + 3] * sc); o.z = pkbf(y[8 * i + 4] * sc, y[8 * i + 5] * sc); o.w = pkbf(y[8 * i + 6] * sc, y[8 * i + 7] * sc);
                        *(GAS v4u*)(dst + 8 * i) = o; } }
            }
#pragma unroll
            for (int pass = 0; pass < 2; ++pass) {
                const bool act = (pass == 0) || (lane < 4);
                const bf16* src = prow + (pass == 0 ? 3072 : 4096) + (pass == 0 ? lane : (lane & 3)) * 16;
                float y[16];
#pragma unroll
                for (int i = 0; i < 4; ++i) { const f32x4 v = bf4_to_f32(*(const GAS u32x2v*)(src + 4 * i)); y[4 * i] = v.x; y[4 * i + 1] = v.y; y[4 * i + 2] = v.z; y[4 * i + 3] = v.w; }
                if ((lane & 3) == 0) {
#pragma unroll
                    for (int i = 0; i < 8; ++i) { const float cs = rt[32 + i], sn = rt[40 + i], a = y[i], b2 = y[i + 8]; y[i] = a * cs - b2 * sn; y[i + 8] = b2 * cs + a * sn; } }
                if (act) { bf16* dst = (pass == 0 ? QI + (size_t)m * 1024 : KI + (size_t)m * 64) + lane * 16;
#pragma unroll
                    for (int i = 0; i < 2; ++i) { v4u o; o.x = pkbf(y[8 * i], y[8 * i + 1]); o.y = pkbf(y[8 * i + 2], y[8 * i + 3]); o.z = pkbf(y[8 * i + 4], y[8 * i + 5]); o.w = pkbf(y[8 * i + 6], y[8 * i + 7]);
                        *(GAS v4u*)(dst + 8 * i) = o; } }
            }
            if (lane < 16) WI[(size_t)m * 16 + lane] = bf2f(prow[4160 + lane]) * 0.03125f;
            { const v4u vv = *(const GAS v4u*)(prow + 2560 + lane * 8);
              const unsigned p0 = vv.x, p1 = vv.y, p2 = vv.z, p3 = vv.w;
              LAS bf16* d = VL + (lane * 8) * 72 + tl;
              d[0] = (bf16)(p0 & 0xffffu); d[72] = (bf16)(p0 >> 16); d[144] = (bf16)(p1 & 0xffffu); d[216] = (bf16)(p1 >> 16);
              d[288] = (bf16)(p2 & 0xffffu); d[360] = (bf16)(p2 >> 16); d[432] = (bf16)(p3 & 0xffffu); d[504] = (bf16)(p3 >> 16); }
        }
        __syncthreads();
        { const int d = tid, g = d >> 7, dd = d & 127, b = blk / 64, t0 = (blk % 64) * 64;
          bf16* dst = VT + ((size_t)((b * 4 + g) * 128 + dd)) * SEQ + t0; const LAS bf16* s = VL + d * 72;
#pragma unroll
          for (int i = 0; i < 8; ++i) *(GAS v4u*)(dst + 8 * i) = *(const LAS v4u*)(s + 8 * i); }
    }
    __syncthreads();
}
__device__ __forceinline__ void phase_indexer(Frame& F) {
    OPAQUE_IDS();
    const int fr = lane & 15, fq = lane >> 4;
    const bf16* QI = (const bf16*)(wsb + WS_QI); const bf16* KI = (const bf16*)(wsb + WS_KI); const float* WI = (const float*)(wsb + WS_WI); float* SC = (float*)(wsb + WS_SC);
    LAS bf16* KL = (LAS bf16*)(F.lds + RING_OFF);
    for (int wi = bid; wi < 256; wi += G) {
        const int g = wi >> 1;
        for (int it = 4 * (wi & 1); it < 4 * (wi & 1) + 4; ++it) {
            const int b = it >> 1; const bool mir = it & 1;
            const int tA = mir ? (SEQ - 1 - (g * 16 + wave * 2)) : (g * 16 + wave * 2), tB = mir ? tA - 1 : tA + 1;
            const int mA = b * SEQ + tA, mB = b * SEQ + tB;
            const bf16x8 a0 = *(const GAS bf16x8*)(QI + (size_t)mA * 1024 + fr * 64 + fq * 8), a1 = *(const GAS bf16x8*)(QI + (size_t)mA * 1024 + fr * 64 + 32 + fq * 8);
            const bf16x8 c0 = *(const GAS bf16x8*)(QI + (size_t)mB * 1024 + fr * 64 + fq * 8), c1 = *(const GAS bf16x8*)(QI + (size_t)mB * 1024 + fr * 64 + 32 + fq * 8);
            const f32x4 w4 = *(const GAS f32x4*)(WI + (size_t)mA * 16 + fq * 4), x4 = *(const GAS f32x4*)(WI + (size_t)mB * 16 + fq * 4);
            const int ntile = (((mir ? (SEQ - 1 - g * 16) : g * 16)) >> 6) + 1, nstage = (ntile + 3) >> 2;
            float* srowA = SC + (size_t)mA * SEQ; float* srowB = SC + (size_t)mB * SEQ; const bf16* kbase = KI + (size_t)b * SEQ * 64;
            v4u sr[4];
#pragma unroll
            for (int i = 0; i < 4; ++i) { const int c = tid + 512 * i; sr[i] = *(const GAS v4u*)(kbase + (size_t)(c >> 3) * 64 + (c & 7) * 8); }
            __syncthreads();
#pragma unroll
            for (int i = 0; i < 4; ++i) { const int c = tid + 512 * i; *(LAS v4u*)(KL + (c >> 3) * 72 + (c & 7) * 8) = sr[i]; }
            __syncthreads();
            for (int st = 0; st < nstage; ++st) {
                const int cb = st & 1, nb = cb ^ 1;
                if (st + 1 < nstage) {
#pragma unroll
                    for (int i = 0; i < 4; ++i) { const int c = tid + 512 * i; sr[i] = *(const GAS v4u*)(kbase + (size_t)((st + 1) * 256 + (c >> 3)) * 64 + (c & 7) * 8); } }
                const LAS bf16* kl = KL + cb * (256 * 72);
                for (int tl = 0; tl < 4; ++tl) {
                    const int tile = st * 4 + tl;
                    if (tile < ntile) {
                        float keepA = 0.f, keepB = 0.f;
#pragma unroll
                        for (int i = 0; i < 4; ++i) {
                            const LAS bf16* kr = kl + (tl * 64 + i * 16 + fr) * 72 + fq * 8;
                            const bf16x8 b0 = *(const LAS bf16x8*)kr, b1 = *(const LAS bf16x8*)(kr + 32);
                            f32x4 accA = (f32x4){0.f, 0.f, 0.f, 0.f}, accB = accA;
                            accA = __builtin_amdgcn_mfma_f32_16x16x32_bf16(a0, b0, accA, 0, 0, 0); accB = __builtin_amdgcn_mfma_f32_16x16x32_bf16(c0, b0, accB, 0, 0, 0);
                            accA = __builtin_amdgcn_mfma_f32_16x16x32_bf16(a1, b1, accA, 0, 0, 0); accB = __builtin_amdgcn_mfma_f32_16x16x32_bf16(c1, b1, accB, 0, 0, 0);
                            float vA = w4.x * fmaxf(accA[0], 0.f) + w4.y * fmaxf(accA[1], 0.f) + w4.z * fmaxf(accA[2], 0.f) + w4.w * fmaxf(accA[3], 0.f);
                            float vB = x4.x * fmaxf(accB[0], 0.f) + x4.y * fmaxf(accB[1], 0.f) + x4.z * fmaxf(accB[2], 0.f) + x4.w * fmaxf(accB[3], 0.f);
                            vA = xsum16(vA); vB = xsum16(vB); vA = xsum32(vA); vB = xsum32(vB);
                            if (fq == i) { keepA = vA; keepB = vB; }
                        }
                        *(GAS float*)(srowA + tile * 64 + lane) = keepA; *(GAS float*)(srowB + tile * 64 + lane) = keepB;
                    }
                }
                if (st + 1 < nstage) {
#pragma unroll
                    for (int i = 0; i < 4; ++i) { const int c = tid + 512 * i; *(LAS v4u*)(KL + nb * (256 * 72) + (c >> 3) * 72 + (c & 7) * 8) = sr[i]; } }
                __syncthreads();
            }
        }
    }
    __syncthreads();
}
__device__ __forceinline__ void phase_bprep2(Frame& F, const LayerIn& L) {
    OPAQUE_IDS();
    const int gw = bid * NWAVES + wave, NGW = G * NWAVES;
    const float* RKV = (const float*)(wsb + WS_RKV); const bf16* LO = (const bf16*)(wsb + WS_LO); float* SI = (float*)(wsb + WS_SCANIN); float* RK = (float*)(wsb + WS_RK); float* C23 = (float*)(wsb + WS_C23);
    for (int m = gw; m < M; m += NGW) {
        const int c0 = lane * 16, head = lane >> 2, b = m / SEQ, t = m % SEQ;
        float kk[16], wv[16], kka[16], kp[16], rr[16]; float ss = 0.f, rk = 0.f, c3 = 0.f;
#pragma unroll
        for (int i4 = 0; i4 < 4; ++i4) {
            const int c = c0 + 4 * i4;
            const f32x4 r = *(const GAS f32x4*)(RKV + (size_t)m * 3072 + c), k = *(const GAS f32x4*)(RKV + (size_t)m * 3072 + 1024 + c);
            const f32x4 dw = bf4_to_f32(*(const GAS u32x2v*)(LO + (size_t)m * 3072 + c)), da = bf4_to_f32(*(const GAS u32x2v*)(LO + (size_t)m * 3072 + 1024 + c));
            const f32x4 w0 = *(const GAS f32x4*)(L.w0 + c), a0 = *(const GAS f32x4*)(L.a0 + c), k_k = *(const GAS f32x4*)(L.k_k + c), k_a = *(const GAS f32x4*)(L.k_a + c), r_k = *(const GAS f32x4*)(L.r_k + c);
#pragma unroll
            for (int j = 0; j < 4; ++j) {
                const int i = 4 * i4 + j;
                const float x = w0[j] + dw[j];
                const float y = -x; const float sp = fmaxf(y, 0.f) + log1pf(__expf(-fabsf(y)));
                const float wlog = -sp - 0.5f;
                wv[i] = __expf(-__expf(wlog));
                const float a = fsig(a0[j] + da[j]);
                const float kkv = k[j] * k_k[j]; kk[i] = kkv; ss += kkv * kkv;
                const float kpv = k[j] * (1.0f + (a - 1.0f) * k_a[j]); kp[i] = kpv;
                kka[i] = a;
                rr[i] = r[j]; rk += r[j] * kpv * r_k[j]; c3 += r[j] * kpv;
            }
        }
        ss += __shfl_xor(ss, 1); ss += __shfl_xor(ss, 2); rk += __shfl_xor(rk, 1); rk += __shfl_xor(rk, 2);
        const float inv = 1.0f / fmaxf(sqrtf(ss), 1e-12f); float c2 = 0.f;
#pragma unroll
        for (int i = 0; i < 16; ++i) { kk[i] *= inv; kka[i] *= kk[i]; c2 += kka[i] * rr[i]; rr[i] *= wv[i]; }
        c2 += __shfl_xor(c2, 1); c2 += __shfl_xor(c2, 2); c3 += __shfl_xor(c3, 1); c3 += __shfl_xor(c3, 2);
        float* dst = SI + ((size_t)(b * 16 + head) * SEQ + t) * 320 + (lane & 3) * 16;
#pragma unroll
        for (int i4 = 0; i4 < 4; ++i4) {
            *(GAS f32x4*)(dst + 0 * 64 + 4 * i4) = (f32x4){kk[4 * i4], kk[4 * i4 + 1], kk[4 * i4 + 2], kk[4 * i4 + 3]};
            *(GAS f32x4*)(dst + 1 * 64 + 4 * i4) = (f32x4){wv[4 * i4], wv[4 * i4 + 1], wv[4 * i4 + 2], wv[4 * i4 + 3]};
            *(GAS f32x4*)(dst + 2 * 64 + 4 * i4) = (f32x4){kka[4 * i4], kka[4 * i4 + 1], kka[4 * i4 + 2], kka[4 * i4 + 3]};
            *(GAS f32x4*)(dst + 3 * 64 + 4 * i4) = (f32x4){kp[4 * i4], kp[4 * i4 + 1], kp[4 * i4 + 2], kp[4 * i4 + 3]};
            *(GAS f32x4*)(dst + 4 * 64 + 4 * i4) = (f32x4){rr[4 * i4], rr[4 * i4 + 1], rr[4 * i4 + 2], rr[4 * i4 + 3]};
        }
        if ((lane & 3) == 0) { RK[(size_t)m * 16 + head] = rk; *(GAS f32x2v*)(C23 + ((size_t)(b * 16 + head) * SEQ + t) * 2) = (f32x2v){c2, c3}; }
    }
}
__device__ __forceinline__ unsigned f2key(float f) { const unsigned u = __float_as_uint(f); return (u & 0x80000000u) ? ~u : (u | 0x80000000u); }
template <int NS> __device__ __forceinline__ void select_query(const float* srow, u64* mout, const int qc, const int lane) {
    unsigned key[NS];
#pragma unroll
    for (int j = 0; j < NS; ++j) key[j] = __float_as_uint(srow[j * 64 + lane]);
    __builtin_amdgcn_sched_barrier(0);
#pragma unroll
    for (int j = 0; j < NS; ++j) key[j] = (j <= qc) ? f2key(__uint_as_float(key[j])) : 0u;
    unsigned prefix = 0u;
    for (int bit = 31; bit >= 0; --bit) {
        const unsigned cand = prefix | (1u << bit); int cnt = 0;
#pragma unroll
        for (int j = 0; j < NS; ++j) { cnt += __popcll(__ballot(key[j] >= cand)); if ((j & 3) == 3) __builtin_amdgcn_sched_barrier(0); }
        if (cnt >= 256) { prefix = cand; if (cnt == 256) break; }
    }
    u64 mine = 0ull;
#pragma unroll
    for (int j = 0; j < NS; ++j) { const u64 mk = __ballot(key[j] >= prefix); if (lane == j) mine = mk; __builtin_amdgcn_sched_barrier(0); }
    mout[lane] = mine;
}
__device__ __forceinline__ void phase_select(Frame& F) {
    OPAQUE_IDS();
    const float* SC = (const float*)(wsb + WS_SC); u64* MK = (u64*)(wsb + WS_MASK);
    for (int gw = bid * NWAVES + wave; gw < SEQ / 2; gw += G * NWAVES) {
        for (int it = 0; it < 8; ++it) {
            const int b = it >> 1, t = (it & 1) ? (SEQ - 1 - gw) : gw, m = b * SEQ + t, qc = t >> 6;
            u64* mout = MK + (size_t)m * 64;
            if (qc < 4) { mout[lane] = (lane <= qc) ? ~0ull : 0ull; continue; }
            const float* srow = SC + (size_t)m * SEQ;
            if (qc < 16) select_query<16>(srow, mout, qc, lane);
            else if (qc < 32) select_query<32>(srow, mout, qc, lane);
            else if (qc < 48) select_query<48>(srow, mout, qc, lane);
            else select_query<64>(srow, mout, qc, lane);
        }
    }
}
__device__ __forceinline__ void scan_item(Frame& F, unsigned char* wsb, const int item, const int tid_in, const int lane_in, const int wave) {
    int lane_ = lane_in; asm volatile("" : "+v"(lane_)); const int lane = lane_, tid = wave * 64 + lane; (void)tid_in;
    const float* C23 = (const float*)(wsb + WS_C23);
    const float* SI = (const float*)(wsb + WS_SCANIN); const float* RKV = (const float*)(wsb + WS_RKV); float* OBR = (float*)(wsb + WS_OBR);
    LAS float* stg = (LAS float*)(F.lds + RING_OFF);
    LAS float* vst = stg + 2 * 10240;
    LAS float* ost = vst + 2 * 1024;
    LAS float* cst = ost + 2 * 1024;
    {
        const int bh = item >> 1, hf = item & 1, b = bh >> 4, h = bh & 15;
        const float* src = SI + (size_t)bh * SEQ * 320;
        const float* csrc = C23 + (size_t)bh * SEQ * 2;
        const float* vsrc = RKV + (size_t)(b * SEQ) * 3072 + 2048 + h * 64 + hf * 32;
        float* odst = OBR + (size_t)(b * SEQ) * 1024 + h * 64 + hf * 32;
        __syncthreads();
        f32x4 ld[5]; float lv[2], lc = 0.f;
#pragma unroll
        for (int i = 0; i < 5; ++i) ld[i] = *(const GAS f32x4*)(src + (size_t)(tid + 512 * i) * 4);
#pragma unroll
        for (int i = 0; i < 2; ++i) { const int e = tid + 512 * i; lv[i] = vsrc[(size_t)(e >> 5) * 3072 + (e & 31)]; }
        if (tid < 64) lc = csrc[tid];
#pragma unroll
        for (int i = 0; i < 5; ++i) *(LAS f32x4*)(stg + (tid + 512 * i) * 4) = ld[i];
        vst[tid] = lv[0]; vst[tid + 512] = lv[1]; if (tid < 64) cst[tid] = lc;
        __syncthreads();
        float S0 = 0.f, S1 = 0.f, S2 = 0.f, S3 = 0.f;
        const int row = wave * 4 + (lane >> 4), kq = (lane & 15) * 4;
        for (int blk = 0; blk < SEQ / 32; ++blk) {
            const int cb = blk & 1, nb = cb ^ 1;
            if (blk > 0) {
#pragma unroll
                for (int i = 0; i < 2; ++i) { const int e = tid + 512 * i; odst[(size_t)((blk - 1) * 32 + (e >> 5)) * 1024 + (e & 31)] = ost[nb * 1024 + e]; } }
            if (blk + 1 < SEQ / 32) {
#pragma unroll
                for (int i = 0; i < 5; ++i) ld[i] = *(const GAS f32x4*)(src + (size_t)(blk + 1) * 10240 + (size_t)(tid + 512 * i) * 4);
#pragma unroll
                for (int i = 0; i < 2; ++i) { const int e = tid + 512 * i; lv[i] = vsrc[(size_t)((blk + 1) * 32 + (e >> 5)) * 3072 + (e & 31)]; }
                if (tid < 64) lc = csrc[(size_t)(blk + 1) * 64 + tid];
            }
            {
                const LAS float* sb = stg + cb * 10240 + kq; const LAS float* vb = vst + cb * 1024 + row; LAS float* ob = ost + cb * 1024 + row; const LAS float* cb2 = cst + cb * 64;
                f32x4 kk = *(const LAS f32x4*)(sb), w = *(const LAS f32x4*)(sb + 64), ka = *(const LAS f32x4*)(sb + 128), kp = *(const LAS f32x4*)(sb + 192), wr = *(const LAS f32x4*)(sb + 256);
                float v = vb[0]; f32x2v cc = *(const LAS f32x2v*)(cb2);
                for (int g8 = 0; g8 < 4; ++g8) {
                    const LAS float* sg = sb + g8 * (8 * 320); const LAS float* vg8 = vb + g8 * (8 * 32); const LAS float* cg = cb2 + g8 * 16;
                    float ov[8];
#pragma unroll
                    for (int s = 0; s < 8; ++s) {
                        f32x4 nkk = kk, nw = w, nka = ka, nkp = kp, nwr = wr; float nv = v; f32x2v ncc = cc;
                        if (s + 1 < 8 || g8 + 1 < 4) { nkk = *(const LAS f32x4*)(sg + (s + 1) * 320); nw = *(const LAS f32x4*)(sg + (s + 1) * 320 + 64); nka = *(const LAS f32x4*)(sg + (s + 1) * 320 + 128); nkp = *(const LAS f32x4*)(sg + (s + 1) * 320 + 192);
                            nwr = *(const LAS f32x4*)(sg + (s + 1) * 320 + 256); nv = vg8[(s + 1) * 32]; ncc = *(const LAS f32x2v*)(cg + 2 * (s + 1)); }
                        float sa = vfma(S1, kk.y, vmul(S0, kk.x)) + vfma(S3, kk.w, vmul(S2, kk.z));
                        float p1 = vfma(S1, wr.y, vmul(S0, wr.x)) + vfma(S3, wr.w, vmul(S2, wr.z));
                        sa += dppf<0xB1>(sa); p1 += dppf<0xB1>(p1); sa += dppf<0x4E>(sa); p1 += dppf<0x4E>(p1); sa += dppf<0x124>(sa); p1 += dppf<0x124>(p1); sa += dppf<0x128>(sa); p1 += dppf<0x128>(p1);
                        S0 = vfma(S0, w.x, vfnma(sa, ka.x, vmul(kp.x, v))); S1 = vfma(S1, w.y, vfnma(sa, ka.y, vmul(kp.y, v))); S2 = vfma(S2, w.z, vfnma(sa, ka.z, vmul(kp.z, v))); S3 = vfma(S3, w.w, vfnma(sa, ka.w, vmul(kp.w, v)));
                        ov[s] = vfma(v, cc.y, vfnma(sa, cc.x, p1));
#if defined(SCAN_XDPP)
                        { float d_ = p1; d_ += dppf<0xB1>(d_); d_ += dppf<0x4E>(d_); d_ += dppf<0x124>(d_); d_ += dppf<0x128>(d_); d_ += dppf<0xB1>(d_); d_ += dppf<0x4E>(d_); d_ += dppf<0x124>(d_); d_ += dppf<0x128>(d_); asm volatile("" :: "v"(d_)); }
#endif
#if defined(SCAN_XLDS)
                        { const f32x4 x0_ = *(const volatile LAS f32x4*)(sg + s * 320), x1_ = *(const volatile LAS f32x4*)(sg + s * 320 + 64), x2_ = *(const volatile LAS f32x4*)(sg + s * 320 + 128), x3_ = *(const volatile LAS f32x4*)(sg + s * 320 + 192), x4_ = *(const volatile LAS f32x4*)(sg + s * 320 + 256);
                          asm volatile("" :: "v"(x0_), "v"(x1_), "v"(x2_), "v"(x3_), "v"(x4_)); }
#endif
#if defined(SCAN_XVALU)
                        { float d_ = p1;
#pragma unroll
                          for (int q_ = 0; q_ < 30; ++q_) { d_ = d_ * 1.0001f + 0.5f; asm volatile("" : "+v"(d_)); }
                          asm volatile("" :: "v"(d_)); }
#endif
                        kk = nkk; w = nw; ka = nka; kp = nkp; wr = nwr; v = nv; cc = ncc;
                        __builtin_amdgcn_sched_barrier(0);
                    }
                    if ((lane & 15) == 0) {
#pragma unroll
                        for (int s = 0; s < 8; ++s) ob[(g8 * 8 + s) * 32] = ov[s]; }
                }
            }
            if (blk + 1 < SEQ / 32) {
#pragma unroll
                for (int i = 0; i < 5; ++i) *(LAS f32x4*)(stg + nb * 10240 + (tid + 512 * i) * 4) = ld[i];
                vst[nb * 1024 + tid] = lv[0]; vst[nb * 1024 + tid + 512] = lv[1]; if (tid < 64) cst[nb * 64 + tid] = lc;
            }
            __syncthreads();
        }
#pragma unroll
        for (int i = 0; i < 2; ++i) { const int e = tid + 512 * i; odst[(size_t)((SEQ / 32 - 1) * 32 + (e >> 5)) * 1024 + (e & 31)] = ost[((SEQ / 32 - 1) & 1) * 1024 + e]; }
    }
    __syncthreads();
}
__device__ __forceinline__ bf16x8 pack8(const float (&v)[8]) {
    v4u o; o.x = pkbf(v[0], v[1]); o.y = pkbf(v[2], v[3]); o.z = pkbf(v[4], v[5]); o.w = pkbf(v[6], v[7]); return __builtin_bit_cast(bf16x8, o);
}
__device__ __forceinline__ void hgrn_item(Frame& F, unsigned char* wsb, const LayerIn& L, const int layer, const int item, const int tid_in, const int lane_in, const int wave) {
    int lane_ = lane_in; asm volatile("" : "+v"(lane_));
    const int lane = lane_, tid = wave * 64 + lane; (void)tid_in;
    const int fr = lane & 15, fq = lane >> 4;
    const bf16* PA = (const bf16*)(wsb + WS_PA); const float* PAF = (const float*)(wsb + WS_PAF); float* OAR = (float*)(wsb + WS_OAR);
    constexpr int NV = 4;
    LAS bf16* AJ = (LAS bf16*)(F.lds + 0);
    LAS float* ET = (LAS float*)(F.lds + 17408);
    LAS bf16* QT = (LAS bf16*)(F.lds + 24576);
    LAS bf16* IT = (LAS bf16*)(F.lds + 41984);
    LAS bf16* ST = (LAS bf16*)(F.lds + 51200);
    LAS float* TOT = (LAS float*)(F.lds + 120832);
    LAS float* RR = (LAS float*)(F.lds + 122880);
    {
        const int b = item >> 4, h = (item >> 1) & 7, js = item & 1;
        const int k = tid & 127, I = tid >> 7;
        float lb = 0.f;
        if (layer == 1) lb = fsig(L.lb1[h * 128 + k] - L.lb0[h * 128 + k]);
        const float omlb = 1.0f - lb;
        f32x4 st[NV];
#pragma unroll
        for (int vb = 0; vb < NV; ++vb) st[vb] = (f32x4){0.f, 0.f, 0.f, 0.f};
        unsigned qreg[16], ireg[2 * NV]; float zreg[16];
        const unsigned qoff = (unsigned)((16 * I) * LDPA + h * 128 + k), foff = (unsigned)((16 * I) * 1024 + h * 128 + k);
        const unsigned ioff0 = (unsigned)((tid >> 6) * LDPA + 2048 + h * 128 + js * 64 + (tid & 63));
        { const bf16* pc = PA + (size_t)(b * SEQ) * LDPA; const float* fc = PAF + (size_t)(b * SEQ) * 1024;
#pragma unroll
          for (int tt = 0; tt < 16; ++tt) { qreg[tt] = pc[qoff + (unsigned)(tt * LDPA)]; zreg[tt] = fc[foff + (unsigned)(tt * 1024)]; }
#pragma unroll
          for (int r = 0; r < 2 * NV; ++r) ireg[r] = pc[ioff0 + (unsigned)(8 * r * LDPA)]; }
        for (int c = 0; c < SEQ / 64; ++c) {
            const int m0 = b * SEQ + c * 64;
            __syncthreads();
            { float cl = 0.f;
#pragma unroll
              for (int tt = 0; tt < 16; ++tt) {
                  if ((tt & 3) == 0) __builtin_amdgcn_sched_barrier(0);
                  const int t = 16 * I + tt;
                  const float qv = __uint_as_float(qreg[tt] << 16), z = zreg[tt];
                  const float ez = __expf(-fminf(fmaxf(z, -80.f), 80.f));
                  const float sig = __builtin_amdgcn_rcpf(1.0f + ez);
                  const float f = lb + omlb * sig;
                  cl += __logf(f);
                  const float kin = omlb * (ez * sig);
                  const float qf = qv * __builtin_amdgcn_rcpf(1.0f + __expf(-qv));
                  QT[t * 136 + k] = (bf16)(pkbf(qf * __expf(cl), 0.f) & 0xffffu);
                  AJ[t * 136 + k] = (bf16)(pkbf(kin * __expf(fminf(-cl, 80.f)), 0.f) & 0xffffu);
              }
              TOT[I * 128 + k] = cl; }
#pragma unroll
            for (int r = 0; r < 2 * NV; ++r) { const int e = tid + 512 * r, t = e >> 6, v = e & 63; IT[v * 72 + t] = (bf16)ireg[r]; }
            if (c + 1 < SEQ / 64) {
                const bf16* pc = PA + (size_t)(m0 + 64) * LDPA; const float* fc = PAF + (size_t)(m0 + 64) * 1024;
#pragma unroll
                for (int tt = 0; tt < 16; ++tt) { qreg[tt] = pc[qoff + (unsigned)(tt * LDPA)]; zreg[tt] = fc[foff + (unsigned)(tt * 1024)]; }
#pragma unroll
                for (int r = 0; r < 2 * NV; ++r) ireg[r] = pc[ioff0 + (unsigned)(8 * r * LDPA)];
            }
            __syncthreads();
            if (tid < 128) { const float t0 = TOT[tid], t1 = TOT[128 + tid], t2 = TOT[256 + tid], t3 = TOT[384 + tid];
                const float R1 = t0, R2 = t0 + t1, R3 = R2 + t2, R4 = R3 + t3;
                RR[tid] = 0.f; RR[128 + tid] = R1; RR[256 + tid] = R2; RR[384 + tid] = R3; RR[512 + tid] = R4;
                const float Rv[5] = {0.f, R1, R2, R3, R4};
#pragma unroll
                for (int Ii = 0; Ii < 5; ++Ii)
#pragma unroll
                    for (int J = 0; J < 4; ++J) if (J <= Ii) { const int idx = (Ii < 4) ? Ii * (Ii + 1) / 2 + J : 10 + J; ET[idx * 128 + tid] = __expf(Rv[Ii] - Rv[J]); } }
            __syncthreads();
            { const int kk = 16 * wave + fr;
#pragma unroll
              for (int Ib = 0; Ib < 4; ++Ib) { const float e = __expf(RR[Ib * 128 + kk]);
#pragma unroll
                  for (int vb = 0; vb < NV; ++vb)
#pragma unroll
                      for (int j = 0; j < 4; ++j) ST[(Ib * 16 * NV + vb * 16 + 4 * fq + j) * 136 + kk] = (bf16)(pkbf(st[vb][j] * e, 0.f) & 0xffffu); } }
            __syncthreads();
            if (wave < 4) {
                const int Iw = wave;
                bf16x8 qb[4];
#pragma unroll
                for (int ks = 0; ks < 4; ++ks) qb[ks] = *(const LAS bf16x8*)(QT + (16 * Iw + fr) * 136 + 32 * ks + 8 * fq);
                f32x4 at[4];
#pragma unroll
                for (int J = 0; J < 4; ++J) { at[J] = (f32x4){0.f, 0.f, 0.f, 0.f};
                    if (J <= Iw) {
#pragma unroll
                        for (int ks = 0; ks < 4; ++ks) {
                            const int s = 16 * J + fr, k0 = 32 * ks + 8 * fq; float a[8];
                            const int eidx = Iw * (Iw + 1) / 2 + J;
                            const v4u ajw = *(const LAS v4u*)(AJ + s * 136 + k0);
                            const f32x4 e0 = *(const LAS f32x4*)(ET + eidx * 128 + k0), e1 = *(const LAS f32x4*)(ET + eidx * 128 + k0 + 4);
                            a[0] = __uint_as_float(ajw.x << 16) * e0[0]; a[1] = __uint_as_float(ajw.x & 0xffff0000u) * e0[1]; a[2] = __uint_as_float(ajw.y << 16) * e0[2]; a[3] = __uint_as_float(ajw.y & 0xffff0000u) * e0[3];
                            a[4] = __uint_as_float(ajw.z << 16) * e1[0]; a[5] = __uint_as_float(ajw.z & 0xffff0000u) * e1[1]; a[6] = __uint_as_float(ajw.w << 16) * e1[2]; a[7] = __uint_as_float(ajw.w & 0xffff0000u) * e1[3];
                            at[J] = __builtin_amdgcn_mfma_f32_16x16x32_bf16(pack8(a), qb[ks], at[J], 0, 0, 0);
                        }
                        if (J == Iw) {
#pragma unroll
                            for (int j = 0; j < 4; ++j) if (4 * fq + j > fr) at[J][j] = 0.f; }
                    } }
                f32x4 oacc[NV];
#pragma unroll
                for (int vb = 0; vb < NV; ++vb) oacc[vb] = (f32x4){0.f, 0.f, 0.f, 0.f};
#pragma unroll
                for (int vb = 0; vb < NV; ++vb)
#pragma unroll
                    for (int ks = 0; ks < 4; ++ks) { const bf16x8 sa = *(const LAS bf16x8*)(ST + (Iw * 16 * NV + vb * 16 + fr) * 136 + 32 * ks + 8 * fq);
                        oacc[vb] = __builtin_amdgcn_mfma_f32_16x16x32_bf16(sa, qb[ks], oacc[vb], 0, 0, 0); if (ks == 3) __builtin_amdgcn_sched_barrier(0); }
#pragma unroll
                for (int p = 0; p < 2; ++p) if (2 * p <= Iw) {
                    float pv[8];
#pragma unroll
                    for (int j = 0; j < 4; ++j) { pv[j] = at[2 * p][j]; pv[4 + j] = at[2 * p + 1][j]; }
                    const bf16x8 pb = pack8(pv);
#pragma unroll
                    for (int vb = 0; vb < NV; ++vb) {
                        const u32x2v i0 = *(const LAS u32x2v*)(IT + (vb * 16 + fr) * 72 + 32 * p + 4 * fq), i1 = *(const LAS u32x2v*)(IT + (vb * 16 + fr) * 72 + 32 * p + 16 + 4 * fq);
                        v4u ia; ia.x = i0.x; ia.y = i0.y; ia.z = i1.x; ia.w = i1.y;
                        oacc[vb] = __builtin_amdgcn_mfma_f32_16x16x32_bf16(__builtin_bit_cast(bf16x8, ia), pb, oacc[vb], 0, 0, 0); __builtin_amdgcn_sched_barrier(0); }
                }
#pragma unroll
                for (int vb = 0; vb < NV; ++vb) *(GAS f32x4*)(OAR + (size_t)(m0 + 16 * Iw + fr) * 1024 + h * 128 + js * 64 + vb * 16 + 4 * fq) = oacc[vb];
            }
            { const int kk = 16 * wave + fr; const float r4 = RR[512 + kk]; const float e4 = __expf(r4);
#pragma unroll
              for (int vb = 0; vb < NV; ++vb) st[vb] = st[vb] * e4;
#pragma unroll
              for (int ks = 0; ks < 2; ++ks) {
                  const int J = 2 * ks + (fq >> 1); const float ej = ET[(10 + J) * 128 + kk]; float kb[8];
#pragma unroll
                  for (int j = 0; j < 8; ++j) { const int s = 32 * ks + 8 * fq + j; kb[j] = bf2f(AJ[s * 136 + kk]) * ej; }
                  const bf16x8 kbp = pack8(kb);
#pragma unroll
                  for (int vb = 0; vb < NV; ++vb) { const bf16x8 ia = *(const LAS bf16x8*)(IT + (vb * 16 + fr) * 72 + 32 * ks + 8 * fq);
                      st[vb] = __builtin_amdgcn_mfma_f32_16x16x32_bf16(ia, kbp, st[vb], 0, 0, 0); __builtin_amdgcn_sched_barrier(0); }
              } }
        }
    }
    __syncthreads();
}

__device__ __forceinline__ void phase_scan_hgrn(Frame& F, const LayerIn& L, const int layer, const int do_scan, const int do_hgrn) {
    OPAQUE_IDS();
    for (int it = bid; it < 192; it += G) {
        if (it < 128) { if (do_scan) scan_item(F, wsb, it, tid, lane, wave); }
        else { if (do_hgrn) hgrn_item(F, wsb, L, layer, it - 128, tid, lane, wave); }
    }
}
__device__ __forceinline__ void phase_attn(Frame& F, const int layer, const float* qgain, const float* kgain) {
    OPAQUE_IDS();
    float negm0;
    { float gq = fmaxf(fabsf(qgain[lane]), fabsf(qgain[lane + 64])), gk = fmaxf(fabsf(kgain[lane]), fabsf(kgain[lane + 64]));
#pragma unroll
      for (int o = 1; o < 64; o <<= 1) { gq = fmaxf(gq, __shfl_xor(gq, o)); gk = fmaxf(gk, __shfl_xor(gk, o)); }
      negm0 = -fmaxf(0.0f, 16.5f * gq * gk - 60.0f); }
    const int fr = lane & 15, fq = lane >> 4;
    const bf16* QC = (const bf16*)(wsb + WS_QC); const bf16* KC = (const bf16*)(wsb + WS_KC); const bf16* VT = (const bf16*)(wsb + WS_VT); const u64* MK = (const u64*)(wsb + WS_MASK);
    bf16* OC = (bf16*)(wsb + WS_OC);
    LAS bf16* KS = (LAS bf16*)(F.lds + 0);
    LAS bf16* VS = (LAS bf16*)(F.lds + 2 * 17408);
    gu32* qhead = F.ctl + CW_QUEUE + 64 * layer;
    LAS unsigned* qslot = (LAS unsigned*)(F.lds + LDSCTL_OFF + 64);
    {
        for (;;) {
            if (tid == 0) *qslot = __hip_atomic_fetch_add(qhead, 1u, __ATOMIC_RELAXED, __HIP_MEMORY_SCOPE_AGENT);
            __syncthreads();
            const unsigned u = *qslot;
            if (u >= 1024u) break;
            const int qc = 63 - (int)(u >> 4), combo = (int)(u & 15u), b = combo >> 2, g = combo & 3;
            const int hq = g * 4 + (wave >> 1), tq0 = qc * 64 + (wave & 1) * 32;
            bf16x8 Qf[2][4];
#pragma unroll
            for (int qb = 0; qb < 2; ++qb)
#pragma unroll
                for (int ks = 0; ks < 4; ++ks) Qf[qb][ks] = *(const GAS bf16x8*)(QC + (size_t)(b * SEQ + tq0 + qb * 16 + fr) * 2048 + hq * 128 + 32 * ks + 8 * fq);
            f32x4 O[8][2];
#pragma unroll
            for (int db = 0; db < 8; ++db) { O[db][0] = (f32x4){0.f, 0.f, 0.f, 0.f}; O[db][1] = (f32x4){0.f, 0.f, 0.f, 0.f}; }
            float lrow[2] = {0.f, 0.f};
            v4u sregK[2], sregV[2];
            const char* kg = (const char*)(KC + (size_t)(b * SEQ) * 512 + g * 128); const char* vg = (const char*)(VT + (size_t)((b * 4 + g) * 128) * SEQ);
            unsigned kgo[2], vgo[2], klo[2], vlo[2];
#pragma unroll
            for (int i = 0; i < 2; ++i) { const int c = tid + 512 * i; kgo[i] = (unsigned)(((c >> 4) * 512 + (c & 15) * 8) * 2); vgo[i] = (unsigned)(((c >> 3) * SEQ + (c & 7) * 8) * 2);
                klo[i] = (unsigned)(((c >> 4) * 136 + (c & 15) * 8) * 2); vlo[i] = (unsigned)(2 * 17408 + ((c >> 3) * 72 + (c & 7) * 8) * 2); }
            __syncthreads();
#pragma unroll
            for (int i = 0; i < 2; ++i) sregK[i] = *(const GAS v4u*)(kg + kgo[i]);
#pragma unroll
            for (int i = 0; i < 2; ++i) sregV[i] = *(const GAS v4u*)(vg + vgo[i]);
#pragma unroll
            for (int i = 0; i < 2; ++i) *(LAS v4u*)(F.lds + klo[i]) = sregK[i];
#pragma unroll
            for (int i = 0; i < 2; ++i) *(LAS v4u*)(F.lds + vlo[i]) = sregV[i];
            if (qc >= 1) {
#pragma unroll
                for (int i = 0; i < 2; ++i) sregK[i] = *(const GAS v4u*)(kg + (size_t)(64 * 512 * 2) + kgo[i]);
#pragma unroll
                for (int i = 0; i < 2; ++i) sregV[i] = *(const GAS v4u*)(vg + (size_t)(64 * 2) + vgo[i]);
            }
            const u64* mkb = MK + (size_t)(b * SEQ) * 64; const unsigned mko0 = (unsigned)((tq0 + fr) * 64), mko1 = mko0 + 16 * 64;
            u64 mn0 = mkb[mko0], mn1 = mkb[mko1];
            __syncthreads();
#define ATT_RDK(ks_, i_) (*(const LAS bf16x8*)((ks_) + (16 * ((i_) >> 2) + fr) * 136 + 32 * ((i_) & 3) + 8 * fq))
#define ATT_S(Sd, ks_) do { bf16x8 rg_[4]; rg_[0] = ATT_RDK(ks_, 0); rg_[1] = ATT_RDK(ks_, 1); rg_[2] = ATT_RDK(ks_, 2); const f32x4 ini_ = (f32x4){negm0, negm0, negm0, negm0}; \
                _Pragma("unroll") for (int i = 0; i < 16; ++i) { if (i + 3 < 16) rg_[(i + 3) & 3] = ATT_RDK(ks_, i + 3); \
                    __builtin_amdgcn_sched_barrier(0); \
                    Sd[i >> 2][0] = __builtin_amdgcn_mfma_f32_16x16x32_bf16(rg_[i & 3], Qf[0][i & 3], (i & 3) ? Sd[i >> 2][0] : ini_, 0, 0, 0); \
                    Sd[i >> 2][1] = __builtin_amdgcn_mfma_f32_16x16x32_bf16(rg_[i & 3], Qf[1][i & 3], (i & 3) ? Sd[i >> 2][1] : ini_, 0, 0, 0); \
                    __builtin_amdgcn_sched_barrier(0); } } while (0)
#define ATT_SM(Sd, mw0_, mw1_, Pd) do { \
                _Pragma("unroll") for (int qb = 0; qb < 2; ++qb) { const u64 mwq = (qb == 0) ? (mw0_) : (mw1_); const unsigned mlo = (unsigned)mwq, mhi = (unsigned)(mwq >> 32); \
                    float ps = 0.f; float p[4][4]; \
                    _Pragma("unroll") for (int kb = 0; kb < 4; ++kb) _Pragma("unroll") for (int j = 0; j < 4; ++j) { unsigned keep_; asm("v_bfe_i32 %0, %1, %2, 1" : "=v"(keep_) : "v"((kb < 2) ? mlo : mhi), "n"(16 * (kb & 1) + j)); \
                        p[kb][j] = __builtin_bit_cast(float, __builtin_bit_cast(unsigned, __builtin_amdgcn_exp2f(Sd[kb][qb][j])) & (unsigned)keep_); ps += p[kb][j]; } \
                    lrow[qb] += ps; \
                    _Pragma("unroll") for (int pp = 0; pp < 2; ++pp) { v4u o_; o_.x = pkbf(p[2 * pp][0], p[2 * pp][1]); o_.y = pkbf(p[2 * pp][2], p[2 * pp][3]); o_.z = pkbf(p[2 * pp + 1][0], p[2 * pp + 1][1]); o_.w = pkbf(p[2 * pp + 1][2], p[2 * pp + 1][3]); \
                        Pd[qb][pp] = __builtin_bit_cast(bf16x8, o_); } } } while (0)
#define ATT_RDV(vs_, i_, h_) (*(const LAS u32x2v*)((vs_) + (16 * ((i_) >> 1) + fr) * 72 + 32 * ((i_) & 1) + 16 * (h_) + 4 * fq))
#define ATT_LDV(vs_, i_, d_) do { const u32x2v v0_ = ATT_RDV(vs_, i_, 0), v1_ = ATT_RDV(vs_, i_, 1); v4u va_; va_.x = v0_.x; va_.y = v0_.y; va_.z = v1_.x; va_.w = v1_.y; d_ = __builtin_bit_cast(bf16x8, va_); } while (0)
#define ATT_PV(Pd, vs_) do { bf16x8 rg_[4]; ATT_LDV(vs_, 0, rg_[0]); ATT_LDV(vs_, 1, rg_[1]); ATT_LDV(vs_, 2, rg_[2]); \
                _Pragma("unroll") for (int i = 0; i < 16; ++i) { if (i + 3 < 16) ATT_LDV(vs_, i + 3, rg_[(i + 3) & 3]); \
                    __builtin_amdgcn_sched_barrier(0); \
                    O[i >> 1][0] = __builtin_amdgcn_mfma_f32_16x16x32_bf16(rg_[i & 3], Pd[0][i & 1], O[i >> 1][0], 0, 0, 0); \
                    O[i >> 1][1] = __builtin_amdgcn_mfma_f32_16x16x32_bf16(rg_[i & 3], Pd[1][i & 1], O[i >> 1][1], 0, 0, 0); \
                    __builtin_amdgcn_sched_barrier(0); } } while (0)
            const bool early = wave < 4;
            bf16x8 Pf[2][2];
            int vcur = 0, vprev = 0;
            for (int kt = 0; kt <= qc; ++kt) {
                const int cb = kt & 1, nb = cb ^ 1; const int vnext = (vcur == 2) ? 0 : vcur + 1;
                const u64 mc0 = mn0 >> (4 * fq), mc1 = mn1 >> (4 * fq);
                if (kt < qc) {
#pragma unroll
                    for (int i = 0; i < 2; ++i) *(LAS v4u*)(F.lds + nb * (64 * 136 * 2) + klo[i]) = sregK[i];
#pragma unroll
                    for (int i = 0; i < 2; ++i) *(LAS v4u*)(F.lds + vnext * (128 * 72 * 2) + vlo[i]) = sregV[i];
                    mn0 = mkb[mko0 + kt + 1]; mn1 = mkb[mko1 + kt + 1];
                }
                if (kt + 1 < qc) {
#pragma unroll
                    for (int i = 0; i < 2; ++i) sregK[i] = *(const GAS v4u*)(kg + (size_t)(kt + 2) * (64 * 512 * 2) + kgo[i]);
#pragma unroll
                    for (int i = 0; i < 2; ++i) sregV[i] = *(const GAS v4u*)(vg + (size_t)(kt + 2) * (64 * 2) + vgo[i]);
                }
                const LAS bf16* ks_ = KS + cb * (64 * 136);
                f32x4 S[4][2];
                if (!early && kt > 0) { ATT_PV(Pf, VS + vprev * (128 * 72)); }
                ATT_S(S, ks_);
                ATT_SM(S, mc0, mc1, Pf);
                if (early) { ATT_PV(Pf, VS + vcur * (128 * 72)); }
                vprev = vcur; vcur = vnext;
                __syncthreads();
            }
            if (!early) { ATT_PV(Pf, VS + vprev * (128 * 72)); }
#undef ATT_S
#undef ATT_SM
#undef ATT_PV
#undef ATT_RDK
#undef ATT_RDV
#undef ATT_LDV
#pragma unroll
            for (int qb = 0; qb < 2; ++qb) {
                float l = lrow[qb]; l += __shfl_xor(l, 16); l += __shfl_xor(l, 32);
                const float inv = 1.0f / l;
                bf16* orow = OC + (size_t)(b * SEQ + tq0 + qb * 16 + fr) * 2048 + hq * 128 + 4 * fq;
#pragma unroll
                for (int db = 0; db < 8; ++db) { u32x2v w; w.x = pkbf(O[db][qb][0] * inv, O[db][qb][1] * inv); w.y = pkbf(O[db][qb][2] * inv, O[db][qb][3] * inv); *(GAS u32x2v*)(orow + 16 * db) = w; }
            }
        }
    }
    __syncthreads();
}
__device__ __forceinline__ void phase_post(Frame& F, const LayerIn& L) {
    OPAQUE_IDS();
    const int gw = bid * NWAVES + wave, NGW = G * NWAVES;
    const float* OAR = (const float*)(wsb + WS_OAR); const float* OBR = (const float*)(wsb + WS_OBR); const bf16* PA = (const bf16*)(wsb + WS_PA);
    const float* RKV = (const float*)(wsb + WS_RKV); const bf16* LO = (const bf16*)(wsb + WS_LO); const float* RK = (const float*)(wsb + WS_RK);
    bf16* OA = (bf16*)(wsb + WS_OA); bf16* OB = (bf16*)(wsb + WS_OB);
    for (int m = gw; m < M; m += NGW) {
        const int c0 = lane * 16;
        { float o[16]; float ss = 0.f;
#pragma unroll
          for (int i = 0; i < 4; ++i) { const f32x4 v = *(const GAS f32x4*)(OAR + (size_t)m * 1024 + c0 + 4 * i); o[4 * i] = v.x; o[4 * i + 1] = v.y; o[4 * i + 2] = v.z; o[4 * i + 3] = v.w; ss += (v.x * v.x + v.y * v.y) + (v.z * v.z + v.w * v.w); }
          ss += __shfl_xor(ss, 1); ss += __shfl_xor(ss, 2); ss += __shfl_xor(ss, 4);
          const float rinv = 1.0f / sqrtf(ss * (1.0f / 128.0f) + NORM_EPS);
          float y[16];
#pragma unroll
          for (int i = 0; i < 4; ++i) { const f32x4 gn = *(const GAS f32x4*)(L.out_norm + (lane & 7) * 16 + 4 * i), gg = bf4_to_f32(*(const GAS u32x2v*)(PA + (size_t)m * LDPA + 3072 + c0 + 4 * i));
#pragma unroll
              for (int j = 0; j < 4; ++j) { const float g = gg[j]; y[4 * i + j] = o[4 * i + j] * rinv * gn[j] * (g / (1.0f + __expf(-g))); } }
#pragma unroll
          for (int i = 0; i < 2; ++i) { v4u w; w.x = pkbf(y[8 * i], y[8 * i + 1]); w.y = pkbf(y[8 * i + 2], y[8 * i + 3]); w.z = pkbf(y[8 * i + 4], y[8 * i + 5]); w.w = pkbf(y[8 * i + 6], y[8 * i + 7]);
              *(GAS v4u*)(OA + (size_t)m * 2048 + c0 + 8 * i) = w; } }
        { float o[16]; float s1 = 0.f;
#pragma unroll
          for (int i = 0; i < 4; ++i) { const f32x4 v = *(const GAS f32x4*)(OBR + (size_t)m * 1024 + c0 + 4 * i); o[4 * i] = v.x; o[4 * i + 1] = v.y; o[4 * i + 2] = v.z; o[4 * i + 3] = v.w; s1 += (v.x + v.y) + (v.z + v.w); }
          s1 += __shfl_xor(s1, 1); s1 += __shfl_xor(s1, 2);
          const float mean = s1 * (1.0f / 64.0f); float s2 = 0.f;
#pragma unroll
          for (int i = 0; i < 16; ++i) { o[i] -= mean; s2 += o[i] * o[i]; }
          s2 += __shfl_xor(s2, 1); s2 += __shfl_xor(s2, 2);
          const float rstd = 1.0f / sqrtf(s2 * (1.0f / 64.0f) + 64e-5f);
          const float rk = RK[(size_t)m * 16 + (lane >> 2)];
          float y[16];
#pragma unroll
          for (int i = 0; i < 4; ++i) { const f32x4 lw = *(const GAS f32x4*)(L.ln_w + c0 + 4 * i), lbv = *(const GAS f32x4*)(L.ln_b + c0 + 4 * i);
              const f32x4 vv = *(const GAS f32x4*)(RKV + (size_t)m * 3072 + 2048 + c0 + 4 * i), gg = bf4_to_f32(*(const GAS u32x2v*)(LO + (size_t)m * 3072 + 2048 + c0 + 4 * i));
#pragma unroll
              for (int j = 0; j < 4; ++j) y[4 * i + j] = (o[4 * i + j] * rstd * lw[j] + lbv[j] + rk * vv[j]) * gg[j]; }
#pragma unroll
          for (int i = 0; i < 2; ++i) { v4u w; w.x = pkbf(y[8 * i], y[8 * i + 1]); w.y = pkbf(y[8 * i + 2], y[8 * i + 3]); w.z = pkbf(y[8 * i + 4], y[8 * i + 5]); w.w = pkbf(y[8 * i + 6], y[8 * i + 7]);
              *(GAS v4u*)(OB + (size_t)m * 2048 + c0 + 8 * i) = w; } }
    }
}
__device__ __forceinline__ void phase_convfix(Frame& F, const LayerIn& L) {
    OPAQUE_IDS();
    const int gw = bid * NWAVES + wave, NGW = G * NWAVES;
    const float* HF = (const float*)(wsb + WS_HALOF); const float* HL = (const float*)(wsb + WS_HALOL); bf16* ACT = (bf16*)(wsb + WS_ACT);
    constexpr int NSTRIP = DFF / 256;
    for (int it = gw; it < NSTRIP * 256; it += NGW) {
        const int sp = it % NSTRIP, blk = it / NSTRIP, c = sp * 256 + lane * 4; const bool hp = (blk % 64) != 0;
        f32x4 wg[3], wu[3];
#pragma unroll
        for (int j = 0; j < 3; ++j) { wg[j] = *(const GAS f32x4*)(L.conv_w + (size_t)j * NUP + c); wu[j] = *(const GAS f32x4*)(L.conv_w + (size_t)j * NUP + DFF + c); }
        const f32x4 bg = *(const GAS f32x4*)(L.conv_b + c), bu = *(const GAS f32x4*)(L.conv_b + DFF + c);
        const f32x4 z = (f32x4){0.f, 0.f, 0.f, 0.f};
        const float* f0 = HF + (size_t)(blk * 2) * NUP; const float* l0 = HL + (size_t)((hp ? blk - 1 : blk) * 2) * NUP;
        const f32x4 g_m2 = hp ? *(const GAS f32x4*)(l0 + c) : z, g_m1 = hp ? *(const GAS f32x4*)(l0 + NUP + c) : z, g_0 = *(const GAS f32x4*)(f0 + c), g_1 = *(const GAS f32x4*)(f0 + NUP + c);
        const f32x4 u_m2 = hp ? *(const GAS f32x4*)(l0 + DFF + c) : z, u_m1 = hp ? *(const GAS f32x4*)(l0 + NUP + DFF + c) : z, u_0 = *(const GAS f32x4*)(f0 + DFF + c), u_1 = *(const GAS f32x4*)(f0 + NUP + DFF + c);
        const f32x4 gc0 = wg[0] * g_m2 + wg[1] * g_m1 + wg[2] * g_0 + bg, uc0 = wu[0] * u_m2 + wu[1] * u_m1 + wu[2] * u_0 + bu;
        const f32x4 gc1 = wg[0] * g_m1 + wg[1] * g_0 + wg[2] * g_1 + bg, uc1 = wu[0] * u_m1 + wu[1] * u_0 + wu[2] * u_1 + bu;
        f32x4 a0, a1;
#pragma unroll
        for (int j = 0; j < 4; ++j) { a0[j] = (gc0[j] / (1.0f + __expf(-gc0[j]))) * uc0[j]; a1[j] = (gc1[j] / (1.0f + __expf(-gc1[j]))) * uc1[j]; }
        u32x2v w0, w1; w0.x = pkbf(a0[0], a0[1]); w0.y = pkbf(a0[2], a0[3]); w1.x = pkbf(a1[0], a1[1]); w1.y = pkbf(a1[2], a1[3]);
        *(GAS u32x2v*)(ACT + (size_t)(blk * 64) * DFF + c) = w0; *(GAS u32x2v*)(ACT + (size_t)(blk * 64 + 1) * DFF + c) = w1;
    }
}
__device__ __forceinline__ void phase_tailfix(Frame& F, const pg8::EpiConvAct& E, const pg8::SplitTailOrder& S, const float* part) {
    OPAQUE_IDS();
    const int half = G >> 1;
    if (S.split() && bid < half) {
        pg8::Unit u; S.next(S.nwg / G, u);
        const int wr = wave >> 2, wc = wave & 3, fr = lane & 15, fq = lane >> 4;
        const f32x4* p0 = (const f32x4*)part + ((size_t)bid * 512 + tid) * 32; const f32x4* p1 = p0 + (size_t)half * (32 * 512);
        constexpr int NUPc = 22016, DFFc = 11008;
        const int row0 = u.pm * 256 + wr * 64 + fr, ch0 = u.pn * 128 + wc * 32 + 8 * fq;
        const int l1 = fq * 16 + ((fr + 15) & 15), l2 = fq * 16 + ((fr + 14) & 15);
#pragma unroll
        for (int n = 0; n < 2; ++n) {
            const int ch = ch0 + 4 * n;
            const f32x4 wg0 = *(const f32x4*)(E.cw + ch), wg1 = *(const f32x4*)(E.cw + NUPc + ch), wg2 = *(const f32x4*)(E.cw + 2 * NUPc + ch), bg = *(const f32x4*)(E.cb + ch);
            const f32x4 wu0 = *(const f32x4*)(E.cw + DFFc + ch), wu1 = *(const f32x4*)(E.cw + NUPc + DFFc + ch), wu2 = *(const f32x4*)(E.cw + 2 * NUPc + DFFc + ch), bu = *(const f32x4*)(E.cb + DFFc + ch);
#pragma unroll
            for (int ai = 0; ai < 2; ++ai) {
                const int blk = u.pm * 4 + ai * 2 + wr;
                f32x4 ag[4], au[4];
#pragma unroll
                for (int m = 0; m < 4; ++m) { const int ig = ((ai * 2 + 0) * 4 + m) * 2 + n, iu = ((ai * 2 + 1) * 4 + m) * 2 + n; ag[m] = p0[ig] + p1[ig]; au[m] = p0[iu] + p1[iu]; }
                f32x4 q1g = (f32x4){0.f, 0.f, 0.f, 0.f}, q2g = q1g, q1u = q1g, q2u = q1g;
#pragma unroll
                for (int m = 0; m < 4; ++m) {
                    const int row = row0 + ai * 128 + m * 16;
                    const float sc = 1.0f / __builtin_sqrtf(E.rs[row] * (1.0f / 4096.0f) + 1e-6f);
                    const f32x4 xg = ag[m] * sc, xu = au[m] * sc;
                    const f32x4 p1g = pg8::shf4(xg, l1), p2g = pg8::shf4(xg, l2), p1u = pg8::shf4(xu, l1), p2u = pg8::shf4(xu, l2);
                    const f32x4 g1 = (fr == 0) ? q1g : p1g, g2 = (fr < 2) ? q2g : p2g, u1 = (fr == 0) ? q1u : p1u, u2 = (fr < 2) ? q2u : p2u;
                    const f32x4 gc = wg0 * g2 + wg1 * g1 + wg2 * xg + bg, uc = wu0 * u2 + wu1 * u1 + wu2 * xu + bu;
                    f32x4 a;
#pragma unroll
                    for (int j = 0; j < 4; ++j) a[j] = gc[j] * pg8::fsigmoid(gc[j]) * uc[j];
                    if (m > 0 || fr >= 2) { u32x2v w; w.x = pg8::cvt_pk_bf16(a[0], a[1]); w.y = pg8::cvt_pk_bf16(a[2], a[3]); *(u32x2v*)(E.ACT + (size_t)row * DFFc + ch) = w; }
                    if (m == 0 && fr < 2) { float* h = E.HF + ((size_t)(blk * 2 + fr)) * NUPc; *(f32x4*)(h + ch) = xg; *(f32x4*)(h + DFFc + ch) = xu; }
                    if (m == 3 && fr >= 14) { float* h = E.HL + ((size_t)(blk * 2 + (fr - 14))) * NUPc; *(f32x4*)(h + ch) = xg; *(f32x4*)(h + DFFc + ch) = xu; }
                    q1g = p1g; q2g = p2g; q1u = p1u; q2u = p2u;
                }
            }
        }
    }
}
#ifndef REPW
#define REPW 1
#endif
#ifndef REPSCAN
#define REPSCAN 1
#endif
#ifndef REPHGRN
#define REPHGRN 1
#endif
#ifndef REPATTN
#define REPATTN 1
#endif
#ifndef REPUP
#define REPUP 1
#endif
#ifndef REPG1
#define REPG1 1
#endif
#ifndef REPA
#define REPA 1
#endif
#ifndef REPB
#define REPB 1
#endif
#ifndef REPC
#define REPC 1
#endif
#ifndef REPD
#define REPD 1
#endif
#ifndef REPSEL
#define REPSEL 1
#endif
#ifndef REPMERGE
#define REPMERGE 1
#endif
#ifndef REPLORA
#define REPLORA 1
#endif
#ifndef REPG1B
#define REPG1B 1
#endif
#ifndef XBAR
#define XBAR 0
#endif
#ifndef REPELT
#define REPELT 1
#endif
#ifndef MK_PER_PHASE
#define MK_PER_PHASE 0
#endif
constexpr int NPH = 14;
struct Args { const void* in[28]; float* out; unsigned char* ws; int ph_lo, ph_hi; };
__device__ __forceinline__ LayerIn make_layer(const Args& args, int layer) {
    LayerIn L;
    L.norm_mix = (const float*)args.in[2] + (size_t)layer * DM; L.w_in = (const float*)args.in[3] + (size_t)layer * DM * IN_COLS;
    L.lb0 = (const float*)args.in[4]; L.lb1 = (const float*)args.in[4] + 1024; L.out_norm = (const float*)args.in[5] + (size_t)layer * 128;
    L.mu = (const float*)args.in[6] + (size_t)layer * 3360; L.w0 = (const float*)args.in[7] + (size_t)layer * 1024; L.w2 = (const float*)args.in[8] + (size_t)layer * 64 * 1024;
    L.a0 = (const float*)args.in[9] + (size_t)layer * 1024; L.a2 = (const float*)args.in[10] + (size_t)layer * 64 * 1024; L.g2 = (const float*)args.in[11] + (size_t)layer * 160 * 1024;
    L.k_k = (const float*)args.in[12] + (size_t)layer * 1024; L.k_a = (const float*)args.in[13] + (size_t)layer * 1024; L.r_k = (const float*)args.in[14] + (size_t)layer * 1024;
    L.ln_w = (const float*)args.in[15] + (size_t)layer * 1024; L.ln_b = (const float*)args.in[16] + (size_t)layer * 1024;
    L.q_norm = (const float*)args.in[17] + (size_t)layer * 128; L.k_norm = (const float*)args.in[18] + (size_t)layer * 128;
    L.wba = (const float*)args.in[19] + (size_t)layer * 1024 * DM; L.wbb = (const float*)args.in[20] + (size_t)layer * 1024 * DM; L.wbc = (const float*)args.in[21] + (size_t)layer * 2048 * DM;
    L.w_out = (const float*)args.in[22] + (size_t)layer * DM * DM; L.norm_ffn = (const float*)args.in[23] + (size_t)layer * DM;
    L.w_up = (const float*)args.in[24] + (size_t)layer * DM * NUP; L.conv_w = (const float*)args.in[25] + (size_t)layer * 3 * NUP; L.conv_b = (const float*)args.in[26] + (size_t)layer * NUP;
    L.w_down = (const float*)args.in[27] + (size_t)layer * DFF * DM;
    return L;
}
__global__ void __launch_bounds__(NWAVES * 64, 2) mk_fwd(Args args) {
    extern __shared__ __attribute__((aligned(16))) unsigned char lds[];
    Frame F;
    F.lds = (LAS unsigned char*)lds;
    F.MISC = (volatile LAS unsigned*)(F.lds + MISC_OFF);
    F.tid = threadIdx.x; F.lane = F.tid & 63; F.wave = __builtin_amdgcn_readfirstlane(F.tid >> 6);
    F.G = gridDim.x; F.ws = args.ws; F.ctl = (gu32*)(args.ws + WS_CTL);
    for (int u = F.tid; u < (LDS_BYTES - LDSCTL_OFF) / 4; u += NWAVES * 64) ((LAS unsigned*)(F.lds + LDSCTL_OFF))[u] = 0u;
    __syncthreads();
    XcdBarrier bar; bar.bar = (unsigned*)(F.ctl + CW_BAR); bar.x = 0; bar.st = nullptr;
    if (!MK_PER_PHASE) bar = xcd_barrier_post((unsigned*)(F.ctl + CW_BAR), F.MISC + 8);
    const int lo = args.ph_lo, hi = args.ph_hi;
    float* xout = args.out;

    if (lo == 0) phase_rope_tables(F, (const int*)args.in[1]);
    for (int layer = 0; layer < 2; ++layer) {
        const float* xin = (layer == 0) ? (const float*)args.in[0] : (const float*)xout;
        const int pbase = layer * NPH;
#ifndef ONLY
#define ONLY -1
#endif
#define IN(k) ((ONLY < 0 || ONLY == (k)) && lo <= pbase + (k) && pbase + (k) < hi)
#define WSL() size_t wz_ = 0; asm volatile("" : "+s"(wz_)); unsigned char* wsb = args.ws + wz_; int bid = blockIdx.x; asm volatile("" : "+s"(bid)); int GG = F.G; asm volatile("" : "+s"(GG)); int wv = F.wave; asm volatile("" : "+s"(wv)); (void)bid; (void)GG; (void)wv; bf16* const XB = (bf16*)(wsb + WS_XB); const float* const RS0 = (const float*)(wsb + WS_RS); float* const SSQ = (float*)(wsb + WS_CTL + CTL_SSQ); (void)XB; (void)RS0; (void)SSQ
#define SEAM(k) do { if (!MK_PER_PHASE && (pbase + (k) + 2 < hi)) xcd_barrier(bar); } while (0)

        if (IN(0)) { WSL(); { const LayerIn L = make_layer(args, layer); for (int r_ = 0; r_ < REPW; ++r_) phase_weights(F, L); } if (layer == 0) phase_norm(F, xin); __syncthreads(); SEAM(0); }
        if (IN(1)) { WSL();
#if !defined(SUB) || SUB==1
            { pg8::Gemm g{XB, (const bf16*)(wsb + WS_WIN), M, NA1, DM}; pg8::StaticOrder S; S.init(M, NA1, GG, bid);
              pg8::EpiP1 E{(bf16*)(wsb + WS_PA), (float*)(wsb + WS_PAF), (bf16*)(wsb + WS_PB), (bf16*)(wsb + WS_PC), layer == 0 ? RS0 : SSQ + M};
              for (int r_ = 0; r_ < REPG1; ++r_) { pg8::gemm_phase<pg8::EpiP1, pg8::StaticOrder, true, true>(F.lds + RING_OFF, g, S, E, wv); __syncthreads(); } }
            __syncthreads();
#endif
        }
        if (IN(1)) { WSL();
#if !defined(SUB) || SUB==2
            { pg8::Gemm g{XB, (const bf16*)(wsb + WS_WIN) + (size_t)NA1 * DM, M, NGT, DM}; pg8::StaticOrder S; S.init(M, NGT, GG, bid);
              pg8::EpiB16<1> E{(bf16*)(wsb + WS_G), NGT, layer == 0 ? RS0 : SSQ + M};
              for (int r_ = 0; r_ < REPG1B; ++r_) { pg8::gemm_phase<pg8::EpiB16<1>, pg8::StaticOrder, true, true>(F.lds + RING_OFF, g, S, E, wv); __syncthreads(); } }
#endif
            __syncthreads(); SEAM(1);
        }
        if (IN(2)) { WSL(); { const LayerIn L = make_layer(args, layer); for (int r_ = 0; r_ < REPELT * REPB; ++r_) phase_prep(F, L); } SEAM(2); }
        if (IN(3)) { WSL();
#if !defined(SUB) || SUB==1
            { pg8::Gemm g{(const bf16*)(wsb + WS_LA), (const bf16*)(wsb + WS_WLORA), M, NLORA, KLORA}; pg8::StaticOrder S; S.init(M, NLORA, GG, bid);
              pg8::EpiB16Plain E{(bf16*)(wsb + WS_LO), NLORA};
              for (int r_ = 0; r_ < REPLORA; ++r_) { pg8::gemm_phase<pg8::EpiB16Plain, pg8::StaticOrder, true, true>(F.lds + RING_OFF, g, S, E, wv); __syncthreads(); } }
#endif
            __syncthreads();
#if !defined(SUB) || SUB==2
            for (int r_ = 0; r_ < REPELT * REPC; ++r_) phase_indexer(F);
#endif
            SEAM(3);
        }
        if (IN(4)) { WSL(); { const LayerIn L = make_layer(args, layer); for (int r_ = 0; r_ < REPELT * REPA; ++r_) phase_bprep2(F, L); } for (int r_ = 0; r_ < REPELT * REPC * REPSEL; ++r_) phase_select(F); SEAM(4); }
        if (IN(5)) { WSL(); __syncthreads();
#if !defined(SUB) || SUB==1 || SUB==2
            { const LayerIn L = make_layer(args, layer);
#ifndef DO_SCAN
#define DO_SCAN 1
#endif
#ifndef DO_HGRN
#define DO_HGRN 1
#endif
              for (int r_ = 0; r_ < (REPSCAN > REPHGRN ? REPSCAN : REPHGRN); ++r_) phase_scan_hgrn(F, L, layer, DO_SCAN && r_ < REPSCAN, DO_HGRN && r_ < REPHGRN);
            }
#endif
#if !defined(SUB) || SUB==3
            { const LayerIn L = make_layer(args, layer); phase_attn(F, layer, L.q_norm, L.k_norm);
#if REPATTN > 1
            phase_attn(F, layer + 2, L.q_norm, L.k_norm);
#endif
            }
#endif
            SEAM(5); }
        for (int xb_ = 0; xb_ < XBAR; ++xb_) xcd_barrier(bar);
        if (IN(6)) { WSL(); { const LayerIn L = make_layer(args, layer); for (int r_ = 0; r_ < REPELT * REPA; ++r_) phase_post(F, L); } SEAM(6); }
        if (IN(7)) { WSL();
          for (int rm_ = 0; rm_ < REPMERGE; ++rm_) {
            __syncthreads();
            { pg8::Gemm g{(const bf16*)(wsb + WS_OA), (const bf16*)(wsb + WS_WA), M, DM, 2048};
              pg8::MergeOrder S; S.init(M, DM, GG, bid);
              static_assert(WS_OB - WS_OA == WS_OC - WS_OB && WS_WB - WS_WA == WS_WC - WS_WB, "merge operands at equal spacing");
              S.A0 = (const bf16*)(wsb + WS_OA); S.sA = (WS_OB - WS_OA) / 2; S.B0 = (const bf16*)(wsb + WS_WA); S.sB = (WS_WB - WS_WA) / 2;
              pg8::EpiMerge3 E{(bf16*)(wsb + WS_MERGED), (const bf16*)(wsb + WS_G)};
              pg8::gemm_phase<pg8::EpiMerge3, pg8::MergeOrder, true, true>(F.lds + RING_OFF, g, S, E, wv); }
            __syncthreads();
          }
            SEAM(7);
        }
        if (IN(8)) { WSL();
            __syncthreads();
            { pg8::Gemm g{(const bf16*)(wsb + WS_MERGED), (const bf16*)(wsb + WS_WOUT), M, DM, DM}; pg8::StaticOrder S; S.init(M, DM, GG, bid);
              pg8::EpiRes E{xin, xout, DM, XB, SSQ + (layer == 0 ? 0 : 2 * M)};
              pg8::gemm_phase<pg8::EpiRes, pg8::StaticOrder, true, true>(F.lds + RING_OFF, g, S, E, wv); }
            __syncthreads(); SEAM(8);
        }
        if (IN(10)) { WSL();
            __syncthreads();
            { const LayerIn L = make_layer(args, layer);
              pg8::Gemm g{XB, (const bf16*)(wsb + WS_WUP), M, NUP, DM}; pg8::SplitTailOrder S; S.init(M, NUP, GG, bid);
              typedef pg8::EpiTail<pg8::EpiConvAct, (long)(WS_ACT - WS_PART)> EpiUp;
              EpiUp E{{(bf16*)(wsb + WS_ACT), SSQ + (layer == 0 ? 0 : 2 * M), L.conv_w, L.conv_b, (float*)(wsb + WS_HALOF), (float*)(wsb + WS_HALOL)}};
              for (int r_ = 0; r_ < REPUP; ++r_) { pg8::gemm_phase<EpiUp, pg8::SplitTailOrder, true, true>(F.lds + RING_OFF, g, S, E, wv); __syncthreads(); } }
            __syncthreads(); SEAM(10);
        }
        if (IN(11)) { WSL();
            { const LayerIn L = make_layer(args, layer);
              pg8::SplitTailOrder S; S.init(M, NUP, GG, bid);
              const pg8::EpiConvAct E{(bf16*)(wsb + WS_ACT), SSQ + (layer == 0 ? 0 : 2 * M), L.conv_w, L.conv_b, (float*)(wsb + WS_HALOF), (float*)(wsb + WS_HALOL)};
              phase_tailfix(F, E, S, (const float*)(wsb + WS_PART)); }
            __syncthreads(); if (!MK_PER_PHASE) xcd_barrier(bar);
            { const LayerIn L = make_layer(args, layer); for (int r_ = 0; r_ < REPELT * REPD; ++r_) phase_convfix(F, L); } SEAM(11); }
        if (IN(12)) { WSL();
            __syncthreads();
            { pg8::Gemm g{(const bf16*)(wsb + WS_ACT), (const bf16*)(wsb + WS_WDN), M, DM, DFF}; pg8::StaticOrder S; S.init(M, DM, GG, bid);
              pg8::EpiRes E{xout, xout, DM, layer == 0 ? XB : nullptr, layer == 0 ? SSQ + M : nullptr};
              pg8::gemm_phase<pg8::EpiRes, pg8::StaticOrder, true, true>(F.lds + RING_OFF, g, S, E, wv); }
            __syncthreads(); SEAM(12);
        }
#undef IN
#undef SEAM
    }
}

extern "C" void kernel_launch(void* const* d_in, const int* in_sizes, int n_in, void* d_out, int out_size, void* d_ws, size_t ws_size, hipStream_t stream) {
    static int grid = 0;
    if (grid == 0) {
        if (n_in != 28 || out_size != M * DM || ws_size < WS_END) { fprintf(stderr, "kernel_launch: unexpected problem (n_in %d, out %d, ws %zu < %zu); nothing launched\n", n_in, out_size, ws_size, (size_t)WS_END); grid = -1; return; }
        int dev = 0, cus = 0, per_cu = 0;
        if (hipGetDevice(&dev) != hipSuccess || hipDeviceGetAttribute(&cus, hipDeviceAttributeMultiprocessorCount, dev) != hipSuccess) { grid = -1; return; }
        if (hipFuncSetAttribute((const void*)mk_fwd, hipFuncAttributeMaxDynamicSharedMemorySize, LDS_BYTES) != hipSuccess) { fprintf(stderr, "kernel_launch: hipFuncSetAttribute failed\n"); grid = -1; return; }
        if (hipOccupancyMaxActiveBlocksPerMultiprocessor(&per_cu, (const void*)mk_fwd, NWAVES * 64, LDS_BYTES) != hipSuccess || per_cu < 1)
            fprintf(stderr, "kernel_launch: note: occupancy query reports %d workgroups per CU\n", per_cu);
        (void)hipGetLastError();
        grid = cus;
    }
    if (grid < 0) return;
    if (hipMemsetAsync((char*)d_ws + WS_CTL, 0, CTL_ZERO_BYTES, stream) != hipSuccess) { fprintf(stderr, "kernel_launch: memset failed\n"); return; }
    Args a{};
    for (int i = 0; i < 28; ++i) a.in[i] = d_in[i];
    a.out = (float*)d_out; a.ws = (unsigned char*)d_ws;
#if MK_PER_PHASE
    for (int p = 0; p < 2 * NPH; ++p) { if (p % NPH == 13) continue; a.ph_lo = p; a.ph_hi = p + 1; hipLaunchKernelGGL(mk_fwd, dim3(grid), dim3(NWAVES * 64), LDS_BYTES, stream, a); }
#else
    a.ph_lo = 0; a.ph_hi = 2 * NPH;
    hipLaunchKernelGGL(mk_fwd, dim3(grid), dim3(NWAVES * 64), LDS_BYTES, stream, a);
#endif
    const hipError_t le = hipPeekAtLastError();
    if (le != hipSuccess) fprintf(stderr, "kernel_launch: launch failed: %s\n", hipGetErrorName(le));
}
```

```cpp
#include <hip/hip_runtime.h>
#include <cstdio>
#include <cstdint>
namespace pg8 {
#define PG8_LAS __attribute__((address_space(3)))
typedef unsigned short bf16_t;
typedef short bf16x8 __attribute__((ext_vector_type(8)));
typedef float f32x4 __attribute__((ext_vector_type(4)));
typedef unsigned u32x4 __attribute__((ext_vector_type(4)));
constexpr int BM = 256, BK = 64, HALF = 128, HTB = HALF * BK * 2  , STAGE_BYTES = 8 * HTB, NXCD = 8, WGM = 8;

__host__ __device__ __forceinline__ int lds_byte(int r, int c) { const int st = (r >> 4) * 2 + (c >> 5), rr = r & 15, cc = c & 31, ob = rr * 64 + cc * 2; return st * 1024 + (ob ^ (((ob >> 9) & 1) << 5)); }
__host__ __device__ __forceinline__ void stage_rc(int b, int& R, int& C) { const int st = b / 1024, sb = b % 1024, swz = sb ^ (((sb >> 9) & 1) << 5); R = (st >> 1) * 16 + swz / 64; C = (st & 1) * 32 + (swz % 64) / 2; }
__host__ __device__ __forceinline__ int perm32(int rho) { const int n = rho >> 4, i = rho & 15; return 8 * (i >> 2) + 4 * n + (i & 3); }

struct Unit { int pm, pn, seg; };
struct Gemm { const bf16_t* A; const bf16_t* Bt; int M, N, K; };

struct StaticOrder {
    int nM, nN, nwg, G, c;
    __host__ __device__ void init(int M, int N, int G_, int c_) { nM = M / BM; nN = N / BM; nwg = nM * nN; G = G_; c = c_; }
    __host__ __device__ __forceinline__ bool next(int i, Unit& u) const {
        const long L = (long)i * G + c; if (L >= nwg) return false;
        int wgid = (int)L; { const int q = nwg / NXCD, r = nwg % NXCD, xcd = wgid % NXCD, off = wgid / NXCD; wgid = (xcd < r ? xcd * (q + 1) : r * (q + 1) + (xcd - r) * q) + off; }
        const int nig = WGM * nN, gid = wgid / nig, fm = gid * WGM, gsz = (nM - fm) < WGM ? (nM - fm) : WGM;
        u.pm = fm + ((wgid % nig) % gsz); u.pn = (wgid % nig) / gsz; return true;
    }
    __device__ __forceinline__ void a_ready(const Unit&) const {}
    __device__ __forceinline__ void done(const Unit&) const {}
    __device__ __forceinline__ const bf16_t* a_base(const Gemm& g, const Unit&) const { return g.A; }
    __device__ __forceinline__ const bf16_t* b_base(const Gemm& g, const Unit&) const { return g.Bt; }
    __device__ __forceinline__ int ntiles(const Unit&, int nt) const { return nt; }
    __device__ __forceinline__ bool keep(const Unit&) const { return false; }
};
struct SplitTailOrder : StaticOrder {
    __host__ __device__ __forceinline__ bool split() const { return (nwg - (nwg / G) * G) * 2 == G; }
    __host__ __device__ __forceinline__ bool next(int i, Unit& u) const {
        const int R = nwg / G; u.seg = 0;
        if (i < R || !split()) return StaticOrder::next(i, u);
        if (i > R) return false;
        const int half = G >> 1; StaticOrder T = *this; T.c = c % half; u.seg = 1 + c / half; return T.next(R, u);
    }
    __device__ __forceinline__ const bf16_t* a_base(const Gemm& g, const Unit& u) const { return g.A + (u.seg == 2 ? (g.K >> 1) : 0); }
    __device__ __forceinline__ const bf16_t* b_base(const Gemm& g, const Unit& u) const { return g.Bt + (u.seg == 2 ? (g.K >> 1) : 0); }
    __device__ __forceinline__ int ntiles(const Unit& u, int nt) const { return u.seg ? (nt >> 1) : nt; }
};
struct MergeOrder : StaticOrder {
    const bf16_t *A0, *B0; size_t sA, sB;
    __device__ __forceinline__ bool next(int i, Unit& u) const { const bool ok = StaticOrder::next(i / 3, u); u.seg = i % 3; return ok; }
    __device__ __forceinline__ const bf16_t* a_base(const Gemm&, const Unit& u) const { return A0 + (size_t)u.seg * sA; }
    __device__ __forceinline__ const bf16_t* b_base(const Gemm&, const Unit& u) const { return B0 + (size_t)u.seg * sB; }
    __device__ __forceinline__ int ntiles(const Unit& u, int) const { return u.seg == 2 ? 32 : 16; }
    __device__ __forceinline__ bool keep(const Unit& u) const { return u.seg < 2; }
};

typedef __bf16 bf16x2_t __attribute__((ext_vector_type(2)));
__device__ __forceinline__ unsigned cvt_pk_bf16(float lo, float hi) { bf16x2_t v; v.x = (__bf16)lo; v.y = (__bf16)hi; return __builtin_bit_cast(unsigned, v); }
typedef unsigned u32x2 __attribute__((ext_vector_type(2)));
#ifndef WT_EPI
#define WT_EPI 0
#endif
__device__ __forceinline__ void st16(const void* base, int byteoff, u32x4 w) {
#if WT_EPI
    const __amdgpu_buffer_rsrc_t r = __builtin_amdgcn_make_buffer_rsrc((void*)base, (short)0, 0x7FFFF000, 0x00020000);
    __builtin_amdgcn_raw_buffer_store_b128(w, r, byteoff, 0, 16);
#else
    *(u32x4*)((char*)base + byteoff) = w;
#endif
}
__device__ __forceinline__ float fsigmoid(float x) { return __builtin_amdgcn_rcpf(1.0f + __expf(-x)); }

struct EpiP1 {
    static constexpr bool PERM = true, AFTER_DRAIN = false;
    bf16_t* PA; float* PAF; bf16_t* PB; bf16_t* PC; const float* rs;
    __device__ __forceinline__ void operator()(const f32x4 (&acc)[2][2][4][2], const Unit& u, int wr, int wc, int fr, int fq) const {
        bf16_t* base; int ld, colt; const bool f32out = (u.pn >= 4 && u.pn < 8);
        if (u.pn < 16) { base = PA; ld = 4096; colt = u.pn * BM; } else if (u.pn < 30) { base = PB; ld = 3584; colt = (u.pn - 16) * BM; } else { base = PC; ld = 4352; colt = (u.pn - 30) * BM; }
        const int row0 = u.pm * BM + wr * 64 + fr, col0 = colt + wc * 32 + 8 * fq;
        float sc[2][4];
#pragma unroll
        for (int ai = 0; ai < 2; ++ai)
#pragma unroll
            for (int m = 0; m < 4; ++m) sc[ai][m] = 1.0f / __builtin_sqrtf(rs[row0 + ai * HALF + m * 16] * (1.0f / 4096.0f) + 1e-6f);
        const int fcol0 = (u.pn - 4) * BM + wc * 32 + 8 * fq;
#pragma unroll
        for (int ai = 0; ai < 2; ++ai)
#pragma unroll
            for (int m = 0; m < 4; ++m) { const int row = row0 + ai * HALF + m * 16; const float s = sc[ai][m]; const int ob = (row * ld + col0) * 2, of = (row * 1024 + fcol0) * 4;
#pragma unroll
                for (int bj = 0; bj < 2; ++bj) { const f32x4 v0 = acc[ai][bj][m][0] * s, v1 = acc[ai][bj][m][1] * s;
                    if (f32out) { st16(PAF, of + bj * HALF * 4, __builtin_bit_cast(u32x4, v0)); st16(PAF, of + bj * HALF * 4 + 16, __builtin_bit_cast(u32x4, v1)); }
                    else { u32x4 w; w.x = cvt_pk_bf16(v0[0], v0[1]); w.y = cvt_pk_bf16(v0[2], v0[3]); w.z = cvt_pk_bf16(v1[0], v1[1]); w.w = cvt_pk_bf16(v1[2], v1[3]); st16(base, ob + bj * HALF * 2, w); } } }
    }
};
template <int ACT> struct EpiB16 {
    static constexpr bool PERM = true, AFTER_DRAIN = false;
    bf16_t* O; int ldc; const float* rs;
    __device__ __forceinline__ void operator()(const f32x4 (&acc)[2][2][4][2], const Unit& u, int wr, int wc, int fr, int fq) const {
        const int row0 = u.pm * BM + wr * 64 + fr, col0 = u.pn * BM + wc * 32 + 8 * fq;
        float sc[2][4];
#pragma unroll
        for (int ai = 0; ai < 2; ++ai)
#pragma unroll
            for (int m = 0; m < 4; ++m) sc[ai][m] = 1.0f / __builtin_sqrtf(rs[row0 + ai * HALF + m * 16] * (1.0f / 4096.0f) + 1e-6f);
#pragma unroll
        for (int ai = 0; ai < 2; ++ai)
#pragma unroll
            for (int m = 0; m < 4; ++m) { const int row = row0 + ai * HALF + m * 16; const float s = sc[ai][m]; const int ob = (row * ldc + col0) * 2;
#pragma unroll
                for (int bj = 0; bj < 2; ++bj) { f32x4 v0 = acc[ai][bj][m][0] * s, v1 = acc[ai][bj][m][1] * s;
                    if (ACT == 1) {
#pragma unroll
                        for (int j = 0; j < 4; ++j) { v0[j] = fsigmoid(v0[j]); v1[j] = fsigmoid(v1[j]); } }
                    u32x4 w; w.x = cvt_pk_bf16(v0[0], v0[1]); w.y = cvt_pk_bf16(v0[2], v0[3]); w.z = cvt_pk_bf16(v1[0], v1[1]); w.w = cvt_pk_bf16(v1[2], v1[3]);
                    st16(O, ob + bj * HALF * 2, w); } }
    }
};
struct EpiB16Plain {
    static constexpr bool PERM = true, AFTER_DRAIN = false;
    bf16_t* O; int ldc;
    __device__ __forceinline__ void operator()(const f32x4 (&acc)[2][2][4][2], const Unit& u, int wr, int wc, int fr, int fq) const {
        const int row0 = u.pm * BM + wr * 64 + fr, col0 = u.pn * BM + wc * 32 + 8 * fq;
#pragma unroll
        for (int ai = 0; ai < 2; ++ai)
#pragma unroll
            for (int m = 0; m < 4; ++m) { const int ob = ((row0 + ai * HALF + m * 16) * ldc + col0) * 2;
#pragma unroll
                for (int bj = 0; bj < 2; ++bj) { const f32x4 v0 = acc[ai][bj][m][0], v1 = acc[ai][bj][m][1];
                    u32x4 w; w.x = cvt_pk_bf16(v0[0], v0[1]); w.y = cvt_pk_bf16(v0[2], v0[3]); w.z = cvt_pk_bf16(v1[0], v1[1]); w.w = cvt_pk_bf16(v1[2], v1[3]);
                    st16(O, ob + bj * HALF * 2, w); } }
    }
};
struct EpiF32 {
    static constexpr bool PERM = false, AFTER_DRAIN = false;
    float* C; int ldc;
    __device__ __forceinline__ void operator()(const f32x4 (&acc)[2][2][4][2], const Unit& u, int wr, int wc, int fr, int fq) const {
        const int row0 = u.pm * BM + wr * 64 + fr, col0 = u.pn * BM + wc * 32 + 4 * fq;
#pragma unroll
        for (int ai = 0; ai < 2; ++ai)
#pragma unroll
            for (int m = 0; m < 4; ++m) { float* rowp = C + (size_t)(row0 + ai * HALF + m * 16) * ldc + col0;
#pragma unroll
                for (int bj = 0; bj < 2; ++bj)
#pragma unroll
                    for (int n = 0; n < 2; ++n) *(f32x4*)(rowp + bj * HALF + n * 16) = acc[ai][bj][m][n]; }
    }
};
template <int MODE> struct EpiMerge {
    static constexpr bool PERM = true, AFTER_DRAIN = false;
    bf16_t* MG; bf16_t* OUT; const bf16_t* G; int goff;
    __device__ __forceinline__ void operator()(const f32x4 (&acc)[2][2][4][2], const Unit& u, int wr, int wc, int fr, int fq) const {
        const int row0 = u.pm * BM + wr * 64 + fr, col0 = u.pn * BM + wc * 32 + 8 * fq;
        u32x4 gcur[2], gnxt[2], mcur[2], mnxt[2];
#define EM_LOAD(gdst, mdst, g_) do { const size_t row_ = (size_t)(row0 + ((g_) >> 2) * HALF + ((g_) & 3) * 16); _Pragma("unroll") for (int q_ = 0; q_ < 2; ++q_) { const int col_ = col0 + q_ * HALF; \
            gdst[q_] = *(const u32x4*)(G + row_ * 12288 + goff + col_); if (MODE >= 1) mdst[q_] = *(const u32x4*)(MG + row_ * 4096 + col_); } } while (0)
#define EM_UNPK(lo, hi, src_) do { const u32x4 t_ = (src_); lo[0] = __uint_as_float(t_[0] << 16); lo[1] = __uint_as_float(t_[0] & 0xffff0000u); lo[2] = __uint_as_float(t_[1] << 16); lo[3] = __uint_as_float(t_[1] & 0xffff0000u); \
            hi[0] = __uint_as_float(t_[2] << 16); hi[1] = __uint_as_float(t_[2] & 0xffff0000u); hi[2] = __uint_as_float(t_[3] << 16); hi[3] = __uint_as_float(t_[3] & 0xffff0000u); } while (0)
        EM_LOAD(gcur, mcur, 0);
#pragma unroll
        for (int g = 0; g < 8; ++g) {
            if (g + 1 < 8) EM_LOAD(gnxt, mnxt, g + 1);
            const int ai = g >> 2, m = g & 3; const size_t row = (size_t)(row0 + ai * HALF + m * 16);
#pragma unroll
            for (int bj = 0; bj < 2; ++bj) { const int col = col0 + bj * HALF;
                f32x4 g0, g1; EM_UNPK(g0, g1, gcur[bj]);
                f32x4 v0 = acc[ai][bj][m][0] * g0, v1 = acc[ai][bj][m][1] * g1;
                if (MODE >= 1) { f32x4 m0, m1; EM_UNPK(m0, m1, mcur[bj]); v0 = v0 + m0; v1 = v1 + m1; }
                u32x4 w; w.x = cvt_pk_bf16(v0[0], v0[1]); w.y = cvt_pk_bf16(v0[2], v0[3]); w.z = cvt_pk_bf16(v1[0], v1[1]); w.w = cvt_pk_bf16(v1[2], v1[3]);
                if (MODE <= 1) *(u32x4*)(MG + row * 4096 + col) = w; else *(u32x4*)(OUT + row * 4096 + col) = w; }
#pragma unroll
            for (int q = 0; q < 2; ++q) { gcur[q] = gnxt[q]; mcur[q] = mnxt[q]; }
        }
#undef EM_LOAD
#undef EM_UNPK
    }
};
struct EpiMerge3 {
    static constexpr bool PERM = true, AFTER_DRAIN = false;
    bf16_t* OUT; const bf16_t* G;
    __device__ __forceinline__ void operator()(f32x4 (&acc)[2][2][4][2], const Unit& u, int wr, int wc, int fr, int fq) const {
        const int row0 = u.pm * BM + wr * 64 + fr, col0 = u.pn * BM + wc * 32 + 8 * fq; const int seg = u.seg;
        const int gnum = (seg == 0 ? 0 : (seg == 1 ? 4096 : 8192)), gden = (seg == 0 ? 4096 : 8192);
        u32x4 ncur[2], nnxt[2], dcur[2], dnxt[2];
#define E3_LOAD(nd, dd, g_) do { const size_t row_ = (size_t)(row0 + ((g_) >> 2) * HALF + ((g_) & 3) * 16); _Pragma("unroll") for (int q_ = 0; q_ < 2; ++q_) { const int col_ = col0 + q_ * HALF; \
            nd[q_] = *(const u32x4*)(G + row_ * 12288 + gnum + col_); dd[q_] = *(const u32x4*)(G + row_ * 12288 + gden + col_); } } while (0)
#define E3_UNPK(lo, hi, src_) do { const u32x4 t_ = (src_); lo[0] = __uint_as_float(t_[0] << 16); lo[1] = __uint_as_float(t_[0] & 0xffff0000u); lo[2] = __uint_as_float(t_[1] << 16); lo[3] = __uint_as_float(t_[1] & 0xffff0000u); \
            hi[0] = __uint_as_float(t_[2] << 16); hi[1] = __uint_as_float(t_[2] & 0xffff0000u); hi[2] = __uint_as_float(t_[3] << 16); hi[3] = __uint_as_float(t_[3] & 0xffff0000u); } while (0)
        E3_LOAD(ncur, dcur, 0);
#pragma unroll
        for (int g = 0; g < 8; ++g) {
            if (g + 1 < 8) E3_LOAD(nnxt, dnxt, g + 1);
            const int ai = g >> 2, m = g & 3; const size_t row = (size_t)(row0 + ai * HALF + m * 16);
#pragma unroll
            for (int bj = 0; bj < 2; ++bj) {
                f32x4 n0, n1, d0, d1; E3_UNPK(n0, n1, ncur[bj]); E3_UNPK(d0, d1, dcur[bj]);
                if (seg > 0) {
#pragma unroll
                    for (int j = 0; j < 4; ++j) { n0[j] = fmaxf(n0[j], 1e-6f); n1[j] = fmaxf(n1[j], 1e-6f); } }
                if (seg < 2) {
#pragma unroll
                    for (int j = 0; j < 4; ++j) { acc[ai][bj][m][0][j] *= n0[j] * __builtin_amdgcn_rcpf(fmaxf(d0[j], 1e-6f)); acc[ai][bj][m][1][j] *= n1[j] * __builtin_amdgcn_rcpf(fmaxf(d1[j], 1e-6f)); }
                } else {
                    const f32x4 v0 = acc[ai][bj][m][0] * n0, v1 = acc[ai][bj][m][1] * n1;
                    u32x4 w; w.x = cvt_pk_bf16(v0[0], v0[1]); w.y = cvt_pk_bf16(v0[2], v0[3]); w.z = cvt_pk_bf16(v1[0], v1[1]); w.w = cvt_pk_bf16(v1[2], v1[3]);
                    st16(OUT, (int)((row * 4096 + col0 + bj * HALF) * 2), w); }
            }
#pragma unroll
            for (int q = 0; q < 2; ++q) { ncur[q] = nnxt[q]; dcur[q] = dnxt[q]; }
        }
#undef E3_LOAD
#undef E3_UNPK
    }
};
struct EpiRes {
    static constexpr bool PERM = false, AFTER_DRAIN = false;
    const float* base; float* out; int ldc; bf16_t* xb; float* ss;
    __device__ __forceinline__ void operator()(const f32x4 (&acc)[2][2][4][2], const Unit& u, int wr, int wc, int fr, int fq) const {
        const int row0 = u.pm * BM + wr * 64 + fr, col0 = u.pn * BM + wc * 32 + 4 * fq;
        f32x4 cur[4], nxt[4];
#define ER_LOAD(dst, g_) do { const size_t off_ = (size_t)(row0 + ((g_) >> 2) * HALF + ((g_) & 3) * 16) * ldc + col0; _Pragma("unroll") for (int q_ = 0; q_ < 4; ++q_) dst[q_] = *(const f32x4*)(base + off_ + (q_ >> 1) * HALF + (q_ & 1) * 16); } while (0)
        ER_LOAD(cur, 0);
        float sq[8];
#pragma unroll
        for (int g = 0; g < 8; ++g) {
            if (g + 1 < 8) ER_LOAD(nxt, g + 1);
            const int ai = g >> 2, m = g & 3; const size_t off = (size_t)(row0 + ai * HALF + m * 16) * ldc + col0;
            float s2 = 0.f;
#pragma unroll
            for (int q = 0; q < 4; ++q) { const f32x4 v = cur[q] + acc[ai][q >> 1][m][q & 1]; *(f32x4*)(out + off + (q >> 1) * HALF + (q & 1) * 16) = v;
                if (xb) { u32x2 w; w.x = cvt_pk_bf16(v[0], v[1]); w.y = cvt_pk_bf16(v[2], v[3]); *(u32x2*)(xb + off + (q >> 1) * HALF + (q & 1) * 16) = w; s2 += (v[0] * v[0] + v[1] * v[1]) + (v[2] * v[2] + v[3] * v[3]); } }
            sq[g] = s2;
#pragma unroll
            for (int q = 0; q < 4; ++q) cur[q] = nxt[q];
        }
#undef ER_LOAD
        if (ss) {
#pragma unroll
            for (int g = 0; g < 8; ++g) { float t = sq[g]; t += __shfl_xor(t, 16); t += __shfl_xor(t, 32);
                if (fq == 0) atomicAdd(ss + row0 + (g >> 2) * HALF + (g & 3) * 16, t); }
        }
    }
};

template <int CTRL> __device__ __forceinline__ f32x4 dpp4(const f32x4 v) { f32x4 r;
    r[0] = __builtin_bit_cast(float, __builtin_amdgcn_update_dpp(0, __builtin_bit_cast(int, v[0]), CTRL, 0xf, 0xf, false)); r[1] = __builtin_bit_cast(float, __builtin_amdgcn_update_dpp(0, __builtin_bit_cast(int, v[1]), CTRL, 0xf, 0xf, false));
    r[2] = __builtin_bit_cast(float, __builtin_amdgcn_update_dpp(0, __builtin_bit_cast(int, v[2]), CTRL, 0xf, 0xf, false)); r[3] = __builtin_bit_cast(float, __builtin_amdgcn_update_dpp(0, __builtin_bit_cast(int, v[3]), CTRL, 0xf, 0xf, false)); return r; }
__device__ __forceinline__ f32x4 shf4(const f32x4 v, const int src) { f32x4 r; r[0] = __shfl(v[0], src); r[1] = __shfl(v[1], src); r[2] = __shfl(v[2], src); r[3] = __shfl(v[3], src); return r; }
struct EpiConvAct {
    static constexpr bool PERM = true, AFTER_DRAIN = false;
    bf16_t* ACT; const float* rs; const float* cw; const float* cb; float* HF; float* HL;
    __device__ __forceinline__ void operator()(const f32x4 (&acc)[2][2][4][2], const Unit& u, int wr, int wc, int fr, int fq) const {
        constexpr int NUPc = 22016, DFFc = 11008;
        const int row0 = u.pm * BM + wr * 64 + fr, ch0 = u.pn * 128 + wc * 32 + 8 * fq;
        const int l1 = fq * 16 + ((fr + 15) & 15), l2 = fq * 16 + ((fr + 14) & 15);
        float sc[2][4];
#pragma unroll
        for (int ai = 0; ai < 2; ++ai)
#pragma unroll
            for (int m = 0; m < 4; ++m) sc[ai][m] = 1.0f / __builtin_sqrtf(rs[row0 + ai * HALF + m * 16] * (1.0f / 4096.0f) + 1e-6f);
#pragma unroll
        for (int n = 0; n < 2; ++n) {
            const int ch = ch0 + 4 * n;
            const f32x4 wg0 = *(const f32x4*)(cw + ch), wg1 = *(const f32x4*)(cw + NUPc + ch), wg2 = *(const f32x4*)(cw + 2 * NUPc + ch), bg = *(const f32x4*)(cb + ch);
            const f32x4 wu0 = *(const f32x4*)(cw + DFFc + ch), wu1 = *(const f32x4*)(cw + NUPc + DFFc + ch), wu2 = *(const f32x4*)(cw + 2 * NUPc + DFFc + ch), bu = *(const f32x4*)(cb + DFFc + ch);
#pragma unroll
            for (int ai = 0; ai < 2; ++ai) {
                const int blk = u.pm * 4 + ai * 2 + wr;
                f32x4 q1g = (f32x4){0.f, 0.f, 0.f, 0.f}, q2g = q1g, q1u = q1g, q2u = q1g;
#pragma unroll
                for (int m = 0; m < 4; ++m) {
                    const int row = row0 + ai * HALF + m * 16;
                    const f32x4 xg = acc[ai][0][m][n] * sc[ai][m], xu = acc[ai][1][m][n] * sc[ai][m];
                    #ifdef CONV_DPP
                    const f32x4 p1g = dpp4<0x121>(xg), p2g = dpp4<0x122>(xg), p1u = dpp4<0x121>(xu), p2u = dpp4<0x122>(xu);
#else
                    const f32x4 p1g = shf4(xg, l1), p2g = shf4(xg, l2), p1u = shf4(xu, l1), p2u = shf4(xu, l2);
#endif
                    const f32x4 g1 = (fr == 0) ? q1g : p1g, g2 = (fr < 2) ? q2g : p2g, u1 = (fr == 0) ? q1u : p1u, u2 = (fr < 2) ? q2u : p2u;
                    const f32x4 gc = wg0 * g2 + wg1 * g1 + wg2 * xg + bg, uc = wu0 * u2 + wu1 * u1 + wu2 * xu + bu;
                    f32x4 a;
#pragma unroll
                    for (int j = 0; j < 4; ++j) a[j] = gc[j] * fsigmoid(gc[j]) * uc[j];
                    if (m > 0 || fr >= 2) { u32x2 w; w.x = cvt_pk_bf16(a[0], a[1]); w.y = cvt_pk_bf16(a[2], a[3]); *(u32x2*)(ACT + (size_t)row * DFFc + ch) = w; }
                    if (m == 0 && fr < 2) { float* h = HF + ((size_t)(blk * 2 + fr)) * NUPc; *(f32x4*)(h + ch) = xg; *(f32x4*)(h + DFFc + ch) = xu; }
                    if (m == 3 && fr >= 14) { float* h = HL + ((size_t)(blk * 2 + (fr - 14))) * NUPc; *(f32x4*)(h + ch) = xg; *(f32x4*)(h + DFFc + ch) = xu; }
                    q1g = p1g; q2g = p2g; q1u = p1u; q2u = p2u;
                }
            }
        }
    }
};
template <class Inner, long PART_BEHIND_ACT> struct EpiTail {
    static constexpr bool PERM = Inner::PERM, AFTER_DRAIN = false;
    Inner in;
    __device__ __forceinline__ void operator()(const f32x4 (&acc)[2][2][4][2], const Unit& u, int wr, int wc, int fr_, int fq_) const {
        int l_; asm volatile("v_mbcnt_lo_u32_b32 %0, -1, 0\n\tv_mbcnt_hi_u32_b32 %0, -1, %0" : "=v"(l_)); const int fr = l_ & 15, fq = l_ >> 4; (void)fr_; (void)fq_;
        if (u.seg == 0) { in(acc, u, wr, wc, fr, fq); return; }
        const int half = (int)(gridDim.x >> 1), cmod = (int)blockIdx.x % half;
        f32x4* dst = (f32x4*)((char*)in.ACT - PART_BEHIND_ACT) + (size_t)((u.seg - 1) * half + cmod) * (32 * 512) + ((wr * 4 + wc) * 64 + fq * 16 + fr);
#pragma unroll
        for (int ai = 0; ai < 2; ++ai)
#pragma unroll
            for (int bj = 0; bj < 2; ++bj)
#pragma unroll
                for (int m = 0; m < 4; ++m)
#pragma unroll
                    for (int n = 0; n < 2; ++n) dst[(((ai * 2 + bj) * 4 + m) * 2 + n) * 512] = acc[ai][bj][m][n];
    }
};
template <class Epi, class Sched, bool ALIGN_EPI = false, bool SP2 = false>
__device__ __forceinline__ void gemm_phase(PG8_LAS unsigned char* lds, const Gemm g, const Sched& S, const Epi& E, const int wave_id) {
    int lane__; asm volatile("v_mbcnt_lo_u32_b32 %0, -1, 0\n\tv_mbcnt_hi_u32_b32 %0, -1, %0" : "=v"(lane__)); const int tid_ = wave_id * 64 + lane__;
    const int tid = tid_, wid = __builtin_amdgcn_readfirstlane(tid >> 6), lane = tid & 63, wr = wid >> 2, wc = wid & 3, fr = lane & 15, fq = lane >> 4;
    int K_ = g.K; asm volatile("" : "+s"(K_));
    const int K = K_, nt = K / BK;
    unsigned voffA[2], voffB[2];
#pragma unroll
    for (int i = 0; i < 2; ++i) { int R, C; stage_rc(tid * 16 + i * 8192, R, C); const int Rb = Epi::PERM ? ((R & ~31) + perm32(R & 31)) : R;
        voffA[i] = (unsigned)(R * K + C) * 2u; voffB[i] = (unsigned)(Rb * K + C) * 2u; }
    const size_t kstep = (size_t)(BK * 2);
    const size_t hstep = (size_t)HALF * K * 2;
    const size_t tstep = 2 * hstep;
    const unsigned ldsw = (unsigned)wid * 1024u;
    const int aoff = lds_byte(wr * 64 + fr, fq * 8), boff = lds_byte(wc * 32 + fr, fq * 8);
#define PG8_SA(b, h) (((b) * 2 + (h)) * HTB)
#define PG8_SB(b, h) ((4 + (b) * 2 + (h)) * HTB)
#define PG8_STAGE(bufoff, gbase, voff) do { _Pragma("unroll") for (int _i = 0; _i < 2; ++_i) \
        __builtin_amdgcn_global_load_lds((const unsigned*)((const char*)(gbase) + (voff)[_i]), (PG8_LAS unsigned*)(lds + (bufoff) + ldsw + _i * 8192), 16, 0, 0); } while (0)
#define PG8_LDA(dst, b, h) do { _Pragma("unroll") for (int m = 0; m < 4; ++m) _Pragma("unroll") for (int k = 0; k < 2; ++k) dst[m][k] = *(const PG8_LAS bf16x8*)(lds + PG8_SA(b, h) + aoff + m * 2048 + k * 1024); } while (0)
#define PG8_LDB(dst, b, h) do { _Pragma("unroll") for (int n = 0; n < 2; ++n) _Pragma("unroll") for (int k = 0; k < 2; ++k) dst[n][k] = *(const PG8_LAS bf16x8*)(lds + PG8_SB(b, h) + boff + n * 2048 + k * 1024); } while (0)
#define PG8_MMA(ai, bj, At, Bt) do { __builtin_amdgcn_s_setprio(1); _Pragma("unroll") for (int m = 0; m < 4; ++m) _Pragma("unroll") for (int n = 0; n < 2; ++n) _Pragma("unroll") for (int k = 0; k < 2; ++k) \
        acc[ai][bj][m][n] = __builtin_amdgcn_mfma_f32_16x16x32_bf16(Bt[n][k], At[m][k], acc[ai][bj][m][n], 0, 0, 0); __builtin_amdgcn_s_setprio(0); } while (0)
#define PG8_WAIT_V(n) asm volatile("s_waitcnt vmcnt(" #n ")" ::: "memory")
#define PG8_WAIT_L(n) asm volatile("s_waitcnt lgkmcnt(" #n ")" ::: "memory")
#define PG8_BAR __builtin_amdgcn_s_barrier()
#define PG8_SCHED __builtin_amdgcn_sched_barrier(0)
    Unit cur, nxt; int ui = 0;
    if (!S.next(0, cur)) return;
    f32x4 acc[2][2][4][2];
#pragma unroll
    for (int a = 0; a < 2; ++a)
#pragma unroll
        for (int b = 0; b < 2; ++b)
#pragma unroll
            for (int m = 0; m < 4; ++m)
#pragma unroll
                for (int n = 0; n < 2; ++n) acc[a][b][m][n] = (f32x4){0.f, 0.f, 0.f, 0.f};
    bf16x8 At[4][2], B0[2][2], B1[2][2];
    const char* cA = (const char*)S.a_base(g, cur) + (size_t)cur.pm * tstep; const char* cB = (const char*)S.b_base(g, cur) + (size_t)cur.pn * tstep;
    S.a_ready(cur);
    if constexpr (SP2) {
        PG8_STAGE(PG8_SB(0, 0), cB, voffB); PG8_STAGE(PG8_SB(0, 1), cB + hstep, voffB); PG8_STAGE(PG8_SA(0, 0), cA, voffA); PG8_STAGE(PG8_SA(0, 1), cA + hstep, voffA);
        if (wr == 1) PG8_BAR;
        PG8_WAIT_V(2); PG8_BAR;
        PG8_STAGE(PG8_SB(1, 0), cB + kstep, voffB); PG8_STAGE(PG8_SA(1, 0), cA + kstep, voffA); PG8_STAGE(PG8_SB(1, 1), cB + hstep + kstep, voffB);
        PG8_WAIT_V(6); PG8_BAR;
    } else {
        PG8_STAGE(PG8_SB(0, 0), cB, voffB); PG8_STAGE(PG8_SA(0, 0), cA, voffA); PG8_STAGE(PG8_SB(0, 1), cB + hstep, voffB); PG8_STAGE(PG8_SA(0, 1), cA + hstep, voffA);
        if (wr == 1) PG8_BAR;
        PG8_WAIT_V(4); PG8_BAR;
        PG8_STAGE(PG8_SB(1, 0), cB + kstep, voffB); PG8_STAGE(PG8_SA(1, 0), cA + kstep, voffA); PG8_STAGE(PG8_SB(1, 1), cB + hstep + kstep, voffB);
        PG8_WAIT_V(6); PG8_BAR;
    }
    for (;;) {
        const bool has_next = S.next(ui + 1, nxt);
        const char* nA = has_next ? (const char*)S.a_base(g, nxt) + (size_t)nxt.pm * tstep : cA; const char* nB = has_next ? (const char*)S.b_base(g, nxt) + (size_t)nxt.pn * tstep : cB;
        const int ntu = S.ntiles(cur, nt);
        for (int t = 0; t < ntu; t += 2) {
            const bool last = (t == ntu - 2);
            const char* a1 = cA + (size_t)(t + 1) * kstep;
            const char* a2 = last ? nA : cA + (size_t)(t + 2) * kstep; const char* b2 = last ? nB : cB + (size_t)(t + 2) * kstep;
            const char* a3 = a2 + kstep; const char* b3 = b2 + kstep;
            if (last && has_next) S.a_ready(nxt);
            if constexpr (SP2) {
            PG8_LDB(B0, 0, 0); PG8_LDB(B1, 0, 1); PG8_SCHED; PG8_LDA(At, 0, 0); PG8_STAGE(PG8_SA(1, 1), a1 + hstep, voffA);
            PG8_WAIT_V(8); PG8_WAIT_L(0); PG8_BAR; PG8_MMA(0, 0, At, B0); PG8_MMA(0, 1, At, B1); PG8_BAR; PG8_SCHED;
            PG8_LDA(At, 0, 1); PG8_STAGE(PG8_SB(0, 0), b2, voffB); PG8_STAGE(PG8_SB(0, 1), b2 + hstep, voffB); PG8_STAGE(PG8_SA(0, 0), a2, voffA);
            PG8_WAIT_V(8); PG8_WAIT_L(0); PG8_BAR; PG8_MMA(1, 0, At, B0); PG8_MMA(1, 1, At, B1); PG8_BAR; PG8_SCHED;
            PG8_LDB(B0, 1, 0); PG8_LDB(B1, 1, 1); PG8_SCHED; PG8_LDA(At, 1, 0); PG8_STAGE(PG8_SA(0, 1), a2 + hstep, voffA);
            PG8_WAIT_V(8); PG8_WAIT_L(0); PG8_BAR; PG8_MMA(0, 0, At, B0); PG8_MMA(0, 1, At, B1); PG8_BAR; PG8_SCHED;
            PG8_LDA(At, 1, 1); PG8_STAGE(PG8_SB(1, 0), b3, voffB); PG8_STAGE(PG8_SB(1, 1), b3 + hstep, voffB); PG8_STAGE(PG8_SA(1, 0), a3, voffA);
            PG8_WAIT_V(8); PG8_WAIT_L(0); PG8_BAR; PG8_MMA(1, 0, At, B0); PG8_MMA(1, 1, At, B1); PG8_BAR; PG8_SCHED;
            } else {
            PG8_LDB(B0, 0, 0); PG8_SCHED; PG8_LDA(At, 0, 0); PG8_STAGE(PG8_SA(1, 1), a1 + hstep, voffA);
            PG8_WAIT_L(8); PG8_BAR; PG8_WAIT_L(0); PG8_MMA(0, 0, At, B0); PG8_BAR; PG8_SCHED;
            PG8_LDB(B1, 0, 1); PG8_STAGE(PG8_SB(0, 0), b2, voffB);
            PG8_BAR; PG8_WAIT_L(0); PG8_MMA(0, 1, At, B1); PG8_BAR;
            PG8_LDA(At, 0, 1); PG8_STAGE(PG8_SA(0, 0), a2, voffA);
            PG8_BAR; PG8_WAIT_L(0); PG8_MMA(1, 0, At, B0); PG8_BAR; PG8_SCHED;
            PG8_STAGE(PG8_SB(0, 1), b2 + hstep, voffB);
            PG8_WAIT_V(6); PG8_BAR; PG8_MMA(1, 1, At, B1); PG8_BAR;
            PG8_LDB(B0, 1, 0); PG8_SCHED; PG8_LDA(At, 1, 0); PG8_STAGE(PG8_SA(0, 1), a2 + hstep, voffA);
            PG8_WAIT_L(8); PG8_BAR; PG8_WAIT_L(0); PG8_MMA(0, 0, At, B0); PG8_BAR; PG8_SCHED;
            PG8_LDB(B1, 1, 1); PG8_STAGE(PG8_SB(1, 0), b3, voffB);
            PG8_BAR; PG8_WAIT_L(0); PG8_MMA(0, 1, At, B1); PG8_BAR;
            PG8_LDA(At, 1, 1); PG8_STAGE(PG8_SA(1, 0), a3, voffA);
            PG8_BAR; PG8_WAIT_L(0); PG8_MMA(1, 0, At, B0); PG8_BAR; PG8_SCHED;
            PG8_STAGE(PG8_SB(1, 1), b3 + hstep, voffB);
            PG8_WAIT_V(6); PG8_BAR; PG8_MMA(1, 1, At, B1); PG8_BAR;
            }
        }
        if constexpr (ALIGN_EPI) { if (wr == 0) PG8_BAR; }
        if constexpr (!Epi::AFTER_DRAIN) { E(acc, cur, wr, wc, fr, fq); S.done(cur); }
        if (!has_next) break;
        if (!S.keep(cur)) {
#pragma unroll
        for (int a = 0; a < 2; ++a)
#pragma unroll
            for (int b = 0; b < 2; ++b)
#pragma unroll
                for (int m = 0; m < 4; ++m)
#pragma unroll
                    for (int n = 0; n < 2; ++n) acc[a][b][m][n] = (f32x4){0.f, 0.f, 0.f, 0.f};
        }
        cur = nxt; cA = nA; cB = nB; ++ui;
        if constexpr (ALIGN_EPI) { if (wr == 1) PG8_BAR; }
    }
    PG8_WAIT_V(0);
    if constexpr (!ALIGN_EPI) { if (wr == 0) PG8_BAR; }
    PG8_BAR;
    if constexpr (Epi::AFTER_DRAIN) { E.fused(acc, cur, wr, wc, fr, fq, lds, wid, lane); S.done(cur); }
#undef PG8_SA
#undef PG8_SB
#undef PG8_STAGE
#undef PG8_LDA
#undef PG8_LDB
#undef PG8_MMA
#undef PG8_WAIT_V
#undef PG8_WAIT_L
#undef PG8_BAR
#undef PG8_SCHED
}
}
constexpr int NB = 4, SEQ = 4096, DM = 4096, M = NB * SEQ;
constexpr int DFF = 11008, NUP = 2 * DFF;
constexpr int IN_COLS = 23920;
constexpr int NA1 = 12032, NGT = 12288, NWIN = NA1 + NGT;
constexpr int LDPA = 4096, LDPB = 3584, LDPC = 4352;
constexpr int NLORA = 3072, KLORA = 384;
constexpr float NORM_EPS = 1e-6f;
constexpr int NWAVES = 8;
constexpr size_t MiB = 1u << 20;
constexpr size_t WS_CTL = 0, CTL_ZERO_BYTES = 1 * MiB;
constexpr size_t WS_WIN = 1 * MiB;
constexpr size_t WS_WA = WS_WIN + (size_t)NWIN * DM * 2;
constexpr size_t WS_WB = WS_WA + (size_t)DM * 2048 * 2;
constexpr size_t WS_WC = WS_WB + (size_t)DM * 2048 * 2;
constexpr size_t WS_WOUT = WS_WC + (size_t)DM * 2048 * 2;
constexpr size_t WS_WUP = WS_WOUT + (size_t)DM * DM * 2;
constexpr size_t WS_WDN = WS_WUP + (size_t)NUP * DM * 2;
constexpr size_t WS_WLORA = WS_WDN + (size_t)DM * DFF * 2;
constexpr size_t WS_XB = WS_WLORA + (size_t)NLORA * KLORA * 2;
constexpr size_t WS_RS = WS_XB + (size_t)M * DM * 2;
constexpr size_t WS_ROPE = WS_RS + (size_t)M * 4;
constexpr size_t WS_R1 = WS_ROPE + (size_t)M * 48 * 4;
constexpr size_t WS_G = WS_R1;
constexpr size_t WS_PA = WS_G + (size_t)M * NGT * 2;
constexpr size_t WS_PAF = WS_PA + (size_t)M * LDPA * 2;
constexpr size_t WS_PB = WS_PA + (size_t)M * LDPA * 4;
constexpr size_t WS_PC = WS_PB + (size_t)M * LDPB * 4;
constexpr size_t WS_R1_END = WS_PC + (size_t)M * LDPC * 4;
constexpr size_t WS_SCANIN = WS_PB;
constexpr size_t WS_MG = WS_PB;
constexpr size_t WS_MERGED = WS_MG + (size_t)M * DM * 4;
constexpr size_t WS_U = WS_R1;
constexpr size_t WS_HALOF = WS_R1;
constexpr size_t WS_HALOL = WS_HALOF + (size_t)256 * 2 * NUP * 4;
constexpr size_t WS_ACT = WS_U + (size_t)M * NUP * 2;
constexpr size_t WS_PART = WS_R1 + 128 * MiB;
static_assert(WS_HALOL + (size_t)256 * 2 * NUP * 4 <= WS_PART && WS_PART + 64 * MiB <= WS_ACT, "tail partials");
static_assert(WS_SCANIN + (size_t)64 * 4096 * 320 * 4 <= WS_R1_END && WS_MERGED + (size_t)M * DM * 2 <= WS_R1_END && WS_ACT + (size_t)M * DFF * 2 <= WS_R1_END, "R1 overlays");
constexpr size_t WS_LA = WS_R1_END;
constexpr size_t WS_LO = WS_LA + (size_t)M * KLORA * 2;
constexpr size_t WS_RKV = WS_LO + (size_t)M * NLORA * 4;
constexpr size_t WS_SC = WS_RKV + (size_t)M * 3072 * 4;
constexpr size_t WS_MASK = WS_SC + (size_t)NB * SEQ * SEQ * 4;
constexpr size_t WS_QC = WS_MASK + (size_t)M * 64 * 8;
constexpr size_t WS_KC = WS_QC + (size_t)M * 2048 * 2;
constexpr size_t WS_VT = WS_KC + (size_t)M * 512 * 2;
constexpr size_t WS_QI = WS_VT + (size_t)M * 512 * 2;
constexpr size_t WS_KI = WS_QI + (size_t)M * 1024 * 2;
constexpr size_t WS_WI = WS_KI + (size_t)M * 64 * 2;
constexpr size_t WS_RK = WS_WI + (size_t)M * 16 * 4;
constexpr size_t WS_C23 = WS_RK + (size_t)M * 16 * 4;
constexpr size_t WS_OAR = WS_C23 + (size_t)M * 16 * 2 * 4;
constexpr size_t WS_OBR = WS_OAR + (size_t)M * 1024 * 4;
constexpr size_t WS_OA = WS_OBR + (size_t)M * 1024 * 4;
constexpr size_t WS_OB = WS_OA + (size_t)M * 2048 * 2;
constexpr size_t WS_OC = WS_OB + (size_t)M * 2048 * 2;
constexpr size_t WS_END = WS_OC + (size_t)M * 2048 * 2;
static_assert(WS_END <= (size_t)3135242240ull, "workspace map exceeds 4x the largest input");
constexpr size_t CTL_SSQ = 256 * 1024;
constexpr int CW_TMO = 0, CW_CODE = 1, CW_BAR = 4096, CW_QUEUE = 8192;
constexpr int RING_OFF = 0, RING_BYTES = 131072;
constexpr int LDSCTL_OFF = RING_BYTES, MISC_OFF = LDSCTL_OFF + 320;
constexpr int LDS_BYTES = 147456;
#define GAS __attribute__((address_space(1)))
#define LAS __attribute__((address_space(3)))
typedef unsigned short bf16;
typedef unsigned v4u __attribute__((ext_vector_type(4)));
typedef float f32x4 __attribute__((ext_vector_type(4)));
typedef short bf16x8 __attribute__((ext_vector_type(8)));
typedef GAS unsigned gu32;
typedef GAS unsigned long long gu64;
#define RLX_AGENT __ATOMIC_RELAXED, __HIP_MEMORY_SCOPE_AGENT
#define LDS_WAIT() asm volatile("s_waitcnt lgkmcnt(0)" ::: "memory")
#define VM_WAIT() asm volatile("s_waitcnt vmcnt(0)" ::: "memory")
__device__ __forceinline__ unsigned long long rt() { return __builtin_amdgcn_s_memrealtime(); }
__device__ __forceinline__ unsigned f2bf(float f) { unsigned u = __builtin_bit_cast(unsigned, f); return (u + 0x7fffu + ((u >> 16) & 1u)) >> 16; }
__device__ __forceinline__ unsigned pk2(float lo, float hi) { return f2bf(lo) | (f2bf(hi) << 16); }

#define XB_TMO      128
#define XB_XCNT(j)  (256  + 64 * (j))
#define XB_XSUB(j)  (1280 + 64 * (j))
#define XB_XGEN(j)  (2304 + 64 * (j))
#define XB_TOP      3328
#define XB_TOPGEN   3392
#define XCD_BAR_WORDS 3456
#define XB_SPIN_CAP (1u << 18)

__device__ __forceinline__ unsigned xb_ld(unsigned* p)              { return __hip_atomic_load(p, __ATOMIC_RELAXED, __HIP_MEMORY_SCOPE_AGENT); }
__device__ __forceinline__ unsigned xb_add(unsigned* p, unsigned v) { return __hip_atomic_fetch_add(p, v, __ATOMIC_RELAXED, __HIP_MEMORY_SCOPE_AGENT); }
__device__ __forceinline__ unsigned xb_xcc_id() { return (unsigned)__builtin_amdgcn_s_getreg((3 << 11) | 20) & 0xFu; }
#define XB_SPIN(cond, bar) do { unsigned _sp = 0; while (cond) { __builtin_amdgcn_s_sleep(1); \
    if ((++_sp & 255u) == 0u) { if (xb_ld(&(bar)[XB_TMO])) break; if (_sp > XB_SPIN_CAP) { atomicAdd(&(bar)[XB_TMO], 1u); break; } } } } while (0)

struct XcdBarrier {
    unsigned* bar; unsigned x;
    volatile LAS unsigned* st;
};

__device__ __forceinline__ XcdBarrier xcd_barrier_post(unsigned* bar, volatile LAS unsigned* st) {
    XcdBarrier b; b.bar = bar; b.x = xb_xcc_id(); b.st = st;
    if (threadIdx.x == 0) (void)xb_add(&bar[XB_XCNT(b.x)], 1u);
    return b;
}
__device__ __forceinline__ void xcd_barrier_complete(unsigned* bar, unsigned x, unsigned& nloc, unsigned& nx) {
    const unsigned G = gridDim.x * gridDim.y * gridDim.z;
    unsigned sum, cnt, mine, sp = 0u;
    for (;;) {
        sum = 0u; cnt = 0u; mine = 0u;
#pragma unroll
        for (unsigned j = 0; j < 16; ++j) { const unsigned c = xb_ld(&bar[XB_XCNT(j)]); sum += c; cnt += (c > 0u) ? 1u : 0u; mine = (j == x) ? c : mine; }
        if (sum == G) break;
        __builtin_amdgcn_s_sleep(1);
        if ((++sp & 255u) == 0u) { if (xb_ld(&bar[XB_TMO])) break; if (sp > XB_SPIN_CAP) { atomicAdd(&bar[XB_TMO], 1u); break; } }
    }
    nloc = mine > 0u ? mine : 1u; nx = cnt > 0u ? cnt : 1u;
}

__device__ __forceinline__ void xcd_barrier(const XcdBarrier& b) {
    asm volatile("s_waitcnt vmcnt(0)" ::: "memory");
    __syncthreads();
    if (threadIdx.x == 0) {
        unsigned* bar = b.bar;
        __builtin_amdgcn_s_waitcnt(0);
        unsigned nloc = b.st[0], nx = b.st[1];
        if (nloc == 0u) { xcd_barrier_complete(bar, b.x, nloc, nx); b.st[0] = nloc; b.st[1] = nx; }
        const unsigned old = xb_add(&bar[XB_XSUB(b.x)], 1u);
        const unsigned gen = old / nloc;
        if (old + 1u == (gen + 1u) * nloc) {
            __builtin_amdgcn_fence(__ATOMIC_RELEASE, "agent");
            asm volatile("s_waitcnt vmcnt(0)" ::: "memory");
            const unsigned og = xb_add(&bar[XB_TOP], 1u);
            const unsigned tg = og / nx;
            if (og + 1u == (tg + 1u) * nx) xb_add(&bar[XB_TOPGEN], 1u);
            else XB_SPIN(xb_ld(&bar[XB_TOPGEN]) == tg, bar);
            __builtin_amdgcn_fence(__ATOMIC_ACQUIRE, "agent");
            xb_add(&bar[XB_XGEN(b.x)], 1u);
            asm volatile("s_waitcnt vmcnt(0)" ::: "memory");
        } else {
            XB_SPIN(xb_ld(&bar[XB_XGEN(b.x)]) == gen, bar);
            __builtin_amdgcn_fence(__ATOMIC_ACQUIRE, "agent");
            asm volatile("s_waitcnt vmcnt(0)" ::: "memory");
        }
    }
    __syncthreads();
}

typedef unsigned u32x2v __attribute__((ext_vector_type(2)));
typedef unsigned long long u64;
typedef float f32x2v __attribute__((ext_vector_type(2)));
struct Frame {
    LAS unsigned char* lds;
    volatile LAS unsigned* MISC;
    gu32* ctl;
    int tid, lane, wave, G;
    unsigned char* ws;
    const void* const* in;
};
#define OPAQUE_IDS() int wave_ = F.wave; asm volatile("" : "+s"(wave_)); const int wave = wave_; int lane_; asm volatile("v_mbcnt_lo_u32_b32 %0, -1, 0\n\tv_mbcnt_hi_u32_b32 %0, -1, %0" : "=v"(lane_)); const int lane = lane_; const int tid = wave * 64 + lane; (void)lane; (void)wave; (void)tid; size_t wz_ = 0; asm volatile("" : "+s"(wz_)); unsigned char* wsb = F.ws + wz_;     int bid_ = blockIdx.x; asm volatile("" : "+s"(bid_)); const int bid = bid_; int G_ = F.G; asm volatile("" : "+s"(G_)); const int G = G_; (void)bid; (void)G
__device__ __forceinline__ float wave_sum(float v) {
#pragma unroll
    for (int o = 1; o < 64; o <<= 1) v += __shfl_xor(v, o);
    return v;
}
__device__ __forceinline__ float bf2f(unsigned short h) { return __uint_as_float(((unsigned)h) << 16); }
__device__ __forceinline__ unsigned pkbf(float lo, float hi) { return pg8::cvt_pk_bf16(lo, hi); }
__device__ __forceinline__ f32x4 bf4_to_f32(u32x2v w) { f32x4 r; r.x = __uint_as_float(w.x << 16); r.y = __uint_as_float(w.x & 0xffff0000u); r.z = __uint_as_float(w.y << 16); r.w = __uint_as_float(w.y & 0xffff0000u); return r; }
__device__ __forceinline__ float fsig(float x) { return 1.0f / (1.0f + __expf(-x)); }
__device__ __forceinline__ float vfma(float a, float b, float c) { float d; asm("v_fma_f32 %0, %1, %2, %3" : "=v"(d) : "v"(a), "v"(b), "v"(c)); return d; }
__device__ __forceinline__ float xsum32(float v) { const unsigned u = __float_as_uint(v); const auto r = __builtin_amdgcn_permlane32_swap(u, u, false, false); return __uint_as_float(r[0]) + __uint_as_float(r[1]); }
__device__ __forceinline__ float xsum16(float v) { const unsigned u = __float_as_uint(v); const auto r = __builtin_amdgcn_permlane16_swap(u, u, false, false); return __uint_as_float(r[0]) + __uint_as_float(r[1]); }
__device__ __forceinline__ float vmul(float a, float b) { float d; asm("v_mul_f32 %0, %1, %2" : "=v"(d) : "v"(a), "v"(b)); return d; }
__device__ __forceinline__ float vfnma(float a, float b, float c) { float d; asm("v_fma_f32 %0, -%1, %2, %3" : "=v"(d) : "v"(a), "v"(b), "v"(c)); return d; }
template <int CTRL> __device__ __forceinline__ float dppf(float v) { return __builtin_bit_cast(float, __builtin_amdgcn_update_dpp(0, __builtin_bit_cast(int, v), CTRL, 0xf, 0xf, false)); }
__device__ __forceinline__ float sum16(float v) { v += dppf<0xB1>(v); v += dppf<0x4E>(v); v += dppf<0x124>(v); v += dppf<0x128>(v); return v; }

template <int MAP> __device__ __forceinline__ int wcol_map(int n) {
    if (MAP == 0) return n;
    if (MAP == 2) { const int tile = n >> 8, r = n & 255; return (r < 128) ? tile * 128 + r : DFF + tile * 128 + (r - 128); }
    if (n < 7456) return n; if (n < 7680) return -1; if (n < 11856) return n - 224; if (n < 12032) return -1; return n - 400;
}
template <int MAP> __device__ __forceinline__ void conv_item(const float* W, int K, int ldw, const float* gain, bf16* WT, LAS float* scr, int item, int nblk, int lane, int ldt = 0) {
    if (ldt == 0) ldt = K;
    const int kb = item / nblk, nb = item % nblk, k0 = 64 * kb, n0 = 32 * nb;
    const int src = wcol_map<MAP>(n0 + (lane & 31));
    float v[32];
    const float* wp = W + (size_t)(k0 + (lane >> 5)) * ldw + (src >= 0 ? src : 0);
#pragma unroll
#ifndef NT_W
#define NT_W 0
#endif
    for (int i = 0; i < 32; ++i) v[i] = (src >= 0) ? (NT_W ? __builtin_nontemporal_load(wp + (size_t)(2 * i) * ldw) : wp[(size_t)(2 * i) * ldw]) : 0.f;
    if (gain) {
#pragma unroll
        for (int i = 0; i < 32; ++i) v[i] *= gain[k0 + 2 * i + (lane >> 5)]; }
#pragma unroll
    for (int i = 0; i < 32; ++i) scr[(2 * i + (lane >> 5)) * 33 + (lane & 31)] = v[i];
    LDS_WAIT(); asm volatile("" ::: "memory");
    const int c = lane & 7;
#pragma unroll
    for (int j = 0; j < 4; ++j) { const int n = (lane >> 3) + 8 * j; const LAS float* s = scr + (8 * c) * 33 + n;
        v4u o; o.x = pkbf(s[0 * 33], s[1 * 33]); o.y = pkbf(s[2 * 33], s[3 * 33]); o.z = pkbf(s[4 * 33], s[5 * 33]); o.w = pkbf(s[6 * 33], s[7 * 33]);
        *(GAS v4u*)(WT + (size_t)(n0 + n) * ldt + k0 + 8 * c) = o; }
    LDS_WAIT(); asm volatile("" ::: "memory");
}
struct LayerIn {
    const float *norm_mix, *w_in, *lb0, *lb1, *out_norm, *mu, *w0, *w2, *a0, *a2, *g2, *k_k, *k_a, *r_k, *ln_w, *ln_b, *q_norm, *k_norm, *wba, *wbb, *wbc, *w_out, *norm_ffn, *w_up, *conv_w, *conv_b, *w_down;
};
__device__ __forceinline__ void phase_weights(Frame& F, const LayerIn& L) {
    OPAQUE_IDS();
    LAS float* scr = (LAS float*)(F.lds + RING_OFF + wave * 16384);
    const int gw = bid * NWAVES + wave, NGW = G * NWAVES;
    constexpr int I_IN = (DM / 64) * (NWIN / 32), I_A = (1024 / 64) * (DM / 32), I_C = (2048 / 64) * (DM / 32), I_O = (DM / 64) * (DM / 32), I_UP = (DM / 64) * (NUP / 32), I_DN = (DFF / 64) * (DM / 32);
    constexpr int NITEMS = I_IN + 2 * I_A + I_C + I_O + I_UP + I_DN;
    bf16* ws = (bf16*)wsb;
    for (int it = gw; it < NITEMS; it += NGW) {
        int r = it;
        if (r < I_IN) { conv_item<1>(L.w_in, DM, IN_COLS, L.norm_mix, (bf16*)(wsb + WS_WIN), scr, r, NWIN / 32, lane); continue; } r -= I_IN;
        if (r < I_A) { conv_item<0>(L.wba, 1024, DM, nullptr, (bf16*)(wsb + WS_WA), scr, r, DM / 32, lane, 2048); continue; } r -= I_A;
        if (r < I_A) { conv_item<0>(L.wbb, 1024, DM, nullptr, (bf16*)(wsb + WS_WB), scr, r, DM / 32, lane, 2048); continue; } r -= I_A;
        if (r < I_C) { conv_item<0>(L.wbc, 2048, DM, nullptr, (bf16*)(wsb + WS_WC), scr, r, DM / 32, lane); continue; } r -= I_C;
        if (r < I_O) { conv_item<0>(L.w_out, DM, DM, nullptr, (bf16*)(wsb + WS_WOUT), scr, r, DM / 32, lane); continue; } r -= I_O;
        if (r < I_UP) { conv_item<2>(L.w_up, DM, NUP, L.norm_ffn, (bf16*)(wsb + WS_WUP), scr, r, NUP / 32, lane); continue; } r -= I_UP;
        conv_item<0>(L.w_down, DFF, DM, nullptr, (bf16*)(wsb + WS_WDN), scr, r, DM / 32, lane);
    }
    (void)ws;
    bf16* WL = (bf16*)(wsb + WS_WLORA);
    for (int e = bid * 512 + tid; e < NLORA * KLORA; e += G * 512) {
        const int n = e / KLORA, k = e % KLORA, seg = n >> 10, col = n & 1023; float v = 0.f;
        if (seg == 0) { if (k < 64) v = L.w2[(size_t)k * 1024 + col]; }
        else if (seg == 1) { if (k >= 64 && k < 128) v = L.a2[(size_t)(k - 64) * 1024 + col]; }
        else { if (k >= 128 && k < 288) v = L.g2[(size_t)(k - 128) * 1024 + col]; }
        WL[e] = (bf16)(pkbf(v, 0.f) & 0xffffu);
    }
}
__device__ __forceinline__ void phase_norm(Frame& F, const float* x) {
    OPAQUE_IDS();
    const int gw = bid * NWAVES + wave, NGW = G * NWAVES;
    bf16* XB = (bf16*)(wsb + WS_XB); float* RS = (float*)(wsb + WS_RS);
    for (int m = gw; m < M; m += NGW) {
        const GAS f32x4* xr = (const GAS f32x4*)(x + (size_t)m * DM) + lane;
        GAS u64* o8 = (GAS u64*)(XB + (size_t)m * DM) + lane;
        float s = 0.f; f32x4 xv[16];
#pragma unroll
        for (int j = 0; j < 16; ++j) xv[j] = xr[64 * j];
#pragma unroll
        for (int j = 0; j < 16; ++j) { const f32x4 v = xv[j]; s += (v.x * v.x + v.y * v.y) + (v.z * v.z + v.w * v.w);
            o8[64 * j] = (u64)pkbf(v.x, v.y) | ((u64)pkbf(v.z, v.w) << 32); }
        s = wave_sum(s);
        if (lane == 0) RS[m] = s;
    }
}
__device__ __forceinline__ void sincos_acc(float angf, float& sn, float& cs) {
    const double x = (double)angf;
    const double q = rint(x * 0.63661977236758134308);
    const double y = (x - q * 1.57079632679489655800) - q * 6.123233995736766036e-17;
    const double y2 = y * y;
    const double sp = y * (1.0 + y2 * (-1.0 / 6 + y2 * (1.0 / 120 + y2 * (-1.0 / 5040 + y2 * (1.0 / 362880 + y2 * (-1.0 / 39916800 + y2 * (1.0 / 6227020800.0)))))));
    const double cp = 1.0 + y2 * (-0.5 + y2 * (1.0 / 24 + y2 * (-1.0 / 720 + y2 * (1.0 / 40320 + y2 * (-1.0 / 3628800 + y2 * (1.0 / 479001600 + y2 * (-1.0 / 87178291200.0)))))));
    const int qi = ((int)(long long)q) & 3;
    double s, c;
    if (qi == 0) { s = sp; c = cp; } else if (qi == 1) { s = cp; c = -sp; } else if (qi == 2) { s = -sp; c = -cp; } else { s = -cp; c = sp; }
    sn = (float)s; cs = (float)c;
}
__device__ __forceinline__ float rope_invf(int i) {
    switch (i) {
    case 0: return 1.000000000e+00f; case 1: return 4.403665960e-01f; case 2: return 1.939227432e-01f; case 3: return 8.539710194e-02f;
    case 4: return 3.760603070e-02f; case 5: return 1.656044088e-02f; case 6: return 7.292664610e-03f; case 7: return 3.211446106e-03f;
    case 8: return 1.414213562e-03f; case 9: return 6.227724371e-04f; case 10: return 2.742481884e-04f; case 11: return 1.207697351e-04f;
    case 12: return 5.318295734e-05f; case 13: return 2.341999971e-05f; case 14: return 1.031338525e-05f; case 15: return 4.541670478e-06f;
    case 16: return 1.000000000e+00f; case 17: return 1.939227432e-01f; case 18: return 3.760603070e-02f; case 19: return 7.292664610e-03f;
    case 20: return 1.414213562e-03f; case 21: return 2.742481884e-04f; case 22: return 5.318295734e-05f; default: return 1.031338525e-05f; }
}
__device__ __forceinline__ void phase_rope_tables(Frame& F, const int* positions) {
    OPAQUE_IDS();
    float* RT = (float*)(wsb + WS_ROPE);
    for (int e = bid * 512 + tid; e < M * 24; e += G * 512) {
        const int m = e / 24, i = e % 24; const float pos = (float)positions[m];
        const float ang = pos * rope_invf(i); float sn, cs; sincos_acc(ang, sn, cs);
        if (i < 16) { RT[(size_t)m * 48 + i] = cs; RT[(size_t)m * 48 + 16 + i] = sn; } else { RT[(size_t)m * 48 + 32 + (i - 16)] = cs; RT[(size_t)m * 48 + 40 + (i - 16)] = sn; }
    }
}
__device__ __forceinline__ void phase_prep(Frame& F, const LayerIn& L) {
    OPAQUE_IDS();
    const int gw = bid * NWAVES + wave, NGW = G * NWAVES;
    const bf16* PB = (const bf16*)(wsb + WS_PB); float* RKV = (float*)(wsb + WS_RKV); bf16* LA = (bf16*)(wsb + WS_LA);
#ifndef REPB1
#define REPB1 1
#endif
#ifndef REPB2
#define REPB2 1
#endif
    f32x4 muv[12];
#pragma unroll
    for (int it = 0; it < 12; ++it) muv[it] = *(const GAS f32x4*)(L.mu + (lane + 64 * it) * 4);
    const int c4x = 768 + lane;
    const f32x4 mux0 = *(const GAS f32x4*)(L.mu + c4x * 4), mux1 = *(const GAS f32x4*)(L.mu + (lane < 8 ? c4x + 64 : c4x) * 4);
    for (int rb1_ = 0; rb1_ < REPB1; ++rb1_)
    for (int m = gw; m < M; m += NGW) {
        const bool has_prev = (m % SEQ) != 0; const float hp = has_prev ? 1.0f : 0.0f;
        const bf16* cur = PB + (size_t)m * LDPB; const bf16* prv = has_prev ? cur - LDPB : cur;
        u32x2v rc[12], rp[12];
#pragma unroll
        for (int it = 0; it < 12; ++it) { const int c = (lane + 64 * it) * 4; rc[it] = *(const GAS u32x2v*)(cur + c); rp[it] = *(const GAS u32x2v*)(prv + c); }
        const u32x2v xc0 = *(const GAS u32x2v*)(cur + c4x * 4), xp0 = *(const GAS u32x2v*)(prv + c4x * 4);
        const u32x2v xc1 = *(const GAS u32x2v*)(cur + (lane < 8 ? c4x + 64 : c4x) * 4), xp1 = *(const GAS u32x2v*)(prv + (lane < 8 ? c4x + 64 : c4x) * 4);
#pragma unroll
        for (int it = 0; it < 12; ++it) {
            const int c = (lane + 64 * it) * 4;
            const f32x4 pc = bf4_to_f32(rc[it]), pp = bf4_to_f32(rp[it]) * hp;
            *(GAS f32x4*)(RKV + (size_t)m * 3072 + c) = pc + (pp - pc) * muv[it];
        }
#pragma unroll
        for (int it = 0; it < 2; ++it) {
            const int c4 = c4x + 64 * it;
            if (it == 0 || lane < 8) { const int c = c4 * 4;
                const f32x4 pc = bf4_to_f32(it == 0 ? xc0 : xc1), pp = bf4_to_f32(it == 0 ? xp0 : xp1) * hp;
                const f32x4 ps = pc + (pp - pc) * (it == 0 ? mux0 : mux1); f32x4 o = ps;
                if (c < 3136) { o.x = tanhf(ps.x); o.y = tanhf(ps.y); o.z = tanhf(ps.z); o.w = tanhf(ps.w); }
                else if (c >= 3200) { o.x = fsig(ps.x); o.y = fsig(ps.y); o.z = fsig(ps.z); o.w = fsig(ps.w); }
                *(GAS u64*)(LA + (size_t)m * KLORA + (c - 3072)) = (u64)pkbf(o.x, o.y) | ((u64)pkbf(o.z, o.w) << 32); }
        }
        if (lane < 24) { u64 z = 0ull; asm volatile("" : "+v"(z)); *(GAS u64*)(LA + (size_t)m * KLORA + 288 + lane * 4) = z; }
    }
    const bf16* PC = (const bf16*)(wsb + WS_PC); const float* RT = (const float*)(wsb + WS_ROPE);
    bf16* QC = (bf16*)(wsb + WS_QC); bf16* KC = (bf16*)(wsb + WS_KC); bf16* VT = (bf16*)(wsb + WS_VT); bf16* QI = (bf16*)(wsb + WS_QI); bf16* KI = (bf16*)(wsb + WS_KI); float* WI = (float*)(wsb + WS_WI);
    LAS bf16* VL = (LAS bf16*)(F.lds + RING_OFF);
    constexpr float QSCALE = 0.08838834764831845f * 1.4426950408889634f;
    for (int rb2_ = 0; rb2_ < REPB2; ++rb2_)
    for (int blk = bid; blk < M / 64; blk += G) {
        __syncthreads();
        for (int tt = 0; tt < 8; ++tt) {
            const int tl = wave * 8 + tt, m = blk * 64 + tl;
            const bf16* prow = PC + (size_t)m * LDPC; const float* rt = RT + (size_t)m * 48;
#pragma unroll
            for (int pass = 0; pass < 2; ++pass) {
                const bool act = (pass == 0) || (lane < 16);
                const bf16* src = prow + (pass == 0 ? 0 : 2048) + (pass == 0 ? lane : (lane & 15)) * 32;     const float* gain = (pass == 0 ? L.q_norm : L.k_norm) + (lane & 3) * 32;
                float y[32]; float ss = 0.f;
#pragma unroll
                for (int i = 0; i < 8; ++i) { const f32x4 v = bf4_to_f32(*(const GAS u32x2v*)(src + 4 * i)); y[4 * i] = v.x; y[4 * i + 1] = v.y; y[4 * i + 2] = v.z; y[4 * i + 3] = v.w; ss += (v.x * v.x + v.y * v.y) + (v.z * v.z + v.w * v.w); }
                ss += __shfl_xor(ss, 1); ss += __shfl_xor(ss, 2);
                const float rinv = 1.0f / sqrtf(ss * (1.0f / 128.0f) + NORM_EPS);
#pragma unroll
                for (int i = 0; i < 32; ++i) y[i] = y[i] * rinv * gain[i];
                if ((lane & 3) == 0) {
#pragma unroll
                    for (int i = 0; i < 16; ++i) { const float cs = rt[i], sn = rt[16 + i], a = y[i], b2 = y[i + 16]; y[i] = a * cs - b2 * sn; y[i + 16] = b2 * cs + a * sn; } }
                const float sc = (pass == 0) ? QSCALE : 1.0f;
                if (act) { bf16* dst = (pass == 0 ? QC + (size_t)m * 2048 : KC + (size_t)m * 512) + lane * 32;
#pragma unroll
                    for (int i = 0; i < 4; ++i) { v4u o; o.x = pkbf(y[8 * i] * sc, y[8 * i + 1] * sc); o.y = pkbf(y[8 * i + 2] * sc, y[8 * i + 3] * sc); o.z = pkbf(y[8 * i + 4] * sc, y[8 * i + 5] * sc); o.w = pkbf(y[8 * i + 6] * sc, y[8 * i + 7] * sc);
                        *(GAS v4u*)(dst + 8 * i) = o; } }
            }
#pragma unroll
            for (int pass = 0; pass < 2; ++pass) {
                const bool act = (pass == 0) || (lane < 4);
                const bf16* src = prow + (pass == 0 ? 3072 : 4096) + (pass == 0 ? lane : (lane & 3)) * 16;
                float y[16];
#pragma unroll
                for (int i = 0; i < 4; ++i) { const f32x4 v = bf4_to_f32(*(const GAS u32x2v*)(src + 4 * i)); y[4 * i] = v.x; y[4 * i + 1] = v.y; y[4 * i + 2] = v.z; y[4 * i + 3] = v.w; }
                if ((lane & 3) == 0) {
#pragma unroll
                    for (int i = 0; i < 8; ++i) { const float cs = rt[32 + i], sn = rt[40 + i], a = y[i], b2 = y[i + 8]; y[i] = a * cs - b2 * sn; y[i + 8] = b2 * cs + a * sn; } }
                if (act) { bf16* dst = (pass == 0 ? QI + (size_t)m * 1024 : KI + (size_t)m * 64) + lane * 16;
#pragma unroll
                    for (int i = 0; i < 2; ++i) { v4u o; o.x = pkbf(y[8 * i], y[8 * i + 1]); o.y = pkbf(y[8 * i + 2], y[8 * i + 3]); o.z = pkbf(y[8 * i + 4], y[8 * i + 5]); o.w = pkbf(y[8 * i + 6], y[8 * i + 7]);
                        *(GAS v4u*)(dst + 8 * i) = o; } }
            }
            if (lane < 16) WI[(size_t)m * 16 + lane] = bf2f(prow[4160 + lane]) * 0.03125f;
            { const v4u vv = *(const GAS v4u*)(prow + 2560 + lane * 8);
              const unsigned p0 = vv.x, p1 = vv.y, p2 = vv.z, p3 = vv.w;
              LAS bf16* d = VL + (lane * 8) * 72 + tl;
              d[0] = (bf16)(p0 & 0xffffu); d[72] = (bf16)(p0 >> 16); d[144] = (bf16)(p1 & 0xffffu); d[216] = (bf16)(p1 >> 16);
              d[288] = (bf16)(p2 & 0xffffu); d[360] = (bf16)(p2 >> 16); d[432] = (bf16)(p3 & 0xffffu); d[504] = (bf16)(p3 >> 16); }
        }
        __syncthreads();
        { const int d = tid, g = d >> 7, dd = d & 127, b = blk / 64, t0 = (blk % 64) * 64;
          bf16* dst = VT + ((size_t)((b * 4 + g) * 128 + dd)) * SEQ + t0; const LAS bf16* s = VL + d * 72;
#pragma unroll
          for (int i = 0; i < 8; ++i) *(GAS v4u*)(dst + 8 * i) = *(const LAS v4u*)(s + 8 * i); }
    }
    __syncthreads();
}
__device__ __forceinline__ void phase_indexer(Frame& F) {
    OPAQUE_IDS();
    const int fr = lane & 15, fq = lane >> 4;
    const bf16* QI = (const bf16*)(wsb + WS_QI); const bf16* KI = (const bf16*)(wsb + WS_KI); const float* WI = (const float*)(wsb + WS_WI); float* SC = (float*)(wsb + WS_SC);
    LAS bf16* KL = (LAS bf16*)(F.lds + RING_OFF);
    for (int wi = bid; wi < 256; wi += G) {
        const int g = wi >> 1;
        for (int it = 4 * (wi & 1); it < 4 * (wi & 1) + 4; ++it) {
            const int b = it >> 1; const bool mir = it & 1;
            const int tA = mir ? (SEQ - 1 - (g * 16 + wave * 2)) : (g * 16 + wave * 2), tB = mir ? tA - 1 : tA + 1;
            const int mA = b * SEQ + tA, mB = b * SEQ + tB;
            const bf16x8 a0 = *(const GAS bf16x8*)(QI + (size_t)mA * 1024 + fr * 64 + fq * 8), a1 = *(const GAS bf16x8*)(QI + (size_t)mA * 1024 + fr * 64 + 32 + fq * 8);
            const bf16x8 c0 = *(const GAS bf16x8*)(QI + (size_t)mB * 1024 + fr * 64 + fq * 8), c1 = *(const GAS bf16x8*)(QI + (size_t)mB * 1024 + fr * 64 + 32 + fq * 8);
            const f32x4 w4 = *(const GAS f32x4*)(WI + (size_t)mA * 16 + fq * 4), x4 = *(const GAS f32x4*)(WI + (size_t)mB * 16 + fq * 4);
            const int ntile = (((mir ? (SEQ - 1 - g * 16) : g * 16)) >> 6) + 1, nstage = (ntile + 3) >> 2;
            float* srowA = SC + (size_t)mA * SEQ; float* srowB = SC + (size_t)mB * SEQ; const bf16* kbase = KI + (size_t)b * SEQ * 64;
            v4u sr[4];
#pragma unroll
            for (int i = 0; i < 4; ++i) { const int c = tid + 512 * i; sr[i] = *(const GAS v4u*)(kbase + (size_t)(c >> 3) * 64 + (c & 7) * 8); }
            __syncthreads();
#pragma unroll
            for (int i = 0; i < 4; ++i) { const int c = tid + 512 * i; *(LAS v4u*)(KL + (c >> 3) * 72 + (c & 7) * 8) = sr[i]; }
            __syncthreads();
            for (int st = 0; st < nstage; ++st) {
                const int cb = st & 1, nb = cb ^ 1;
                if (st + 1 < nstage) {
#pragma unroll
                    for (int i = 0; i < 4; ++i) { const int c = tid + 512 * i; sr[i] = *(const GAS v4u*)(kbase + (size_t)((st + 1) * 256 + (c >> 3)) * 64 + (c & 7) * 8); } }
                const LAS bf16* kl = KL + cb * (256 * 72);
                for (int tl = 0; tl < 4; ++tl) {
                    const int tile = st * 4 + tl;
                    if (tile < ntile) {
                        float keepA = 0.f, keepB = 0.f;
#pragma unroll
                        for (int i = 0; i < 4; ++i) {
                            const LAS bf16* kr = kl + (tl * 64 + i * 16 + fr) * 72 + fq * 8;
                            const bf16x8 b0 = *(const LAS bf16x8*)kr, b1 = *(const LAS bf16x8*)(kr + 32);
                            f32x4 accA = (f32x4){0.f, 0.f, 0.f, 0.f}, accB = accA;
                            accA = __builtin_amdgcn_mfma_f32_16x16x32_bf16(a0, b0, accA, 0, 0, 0); accB = __builtin_amdgcn_mfma_f32_16x16x32_bf16(c0, b0, accB, 0, 0, 0);
                            accA = __builtin_amdgcn_mfma_f32_16x16x32_bf16(a1, b1, accA, 0, 0, 0); accB = __builtin_amdgcn_mfma_f32_16x16x32_bf16(c1, b1, accB, 0, 0, 0);
                            float vA = w4.x * fmaxf(accA[0], 0.f) + w4.y * fmaxf(accA[1], 0.f) + w4.z * fmaxf(accA[2], 0.f) + w4.w * fmaxf(accA[3], 0.f);
                            float vB = x4.x * fmaxf(accB[0], 0.f) + x4.y * fmaxf(accB[1], 0.f) + x4.z * fmaxf(accB[2], 0.f) + x4.w * fmaxf(accB[3], 0.f);
                            vA = xsum16(vA); vB = xsum16(vB); vA = xsum32(vA); vB = xsum32(vB);
                            if (fq == i) { keepA = vA; keepB = vB; }
                        }
                        *(GAS float*)(srowA + tile * 64 + lane) = keepA; *(GAS float*)(srowB + tile * 64 + lane) = keepB;
                    }
                }
                if (st + 1 < nstage) {
#pragma unroll
                    for (int i = 0; i < 4; ++i) { const int c = tid + 512 * i; *(LAS v4u*)(KL + nb * (256 * 72) + (c >> 3) * 72 + (c & 7) * 8) = sr[i]; } }
                __syncthreads();
            }
        }
    }
    __syncthreads();
}
__device__ __forceinline__ void phase_bprep2(Frame& F, const LayerIn& L) {
    OPAQUE_IDS();
    const int gw = bid * NWAVES + wave, NGW = G * NWAVES;
    const float* RKV = (const float*)(wsb + WS_RKV); const bf16* LO = (const bf16*)(wsb + WS_LO); float* SI = (float*)(wsb + WS_SCANIN); float* RK = (float*)(wsb + WS_RK); float* C23 = (float*)(wsb + WS_C23);
    for (int m = gw; m < M; m += NGW) {
        const int c0 = lane * 16, head = lane >> 2, b = m / SEQ, t = m % SEQ;
        float kk[16], wv[16], kka[16], kp[16], rr[16]; float ss = 0.f, rk = 0.f, c3 = 0.f;
#pragma unroll
        for (int i4 = 0; i4 < 4; ++i4) {
            const int c = c0 + 4 * i4;
            const f32x4 r = *(const GAS f32x4*)(RKV + (size_t)m * 3072 + c), k = *(const GAS f32x4*)(RKV + (size_t)m * 3072 + 1024 + c);
            const f32x4 dw = bf4_to_f32(*(const GAS u32x2v*)(LO + (size_t)m * 3072 + c)), da = bf4_to_f32(*(const GAS u32x2v*)(LO + (size_t)m * 3072 + 1024 + c));
            const f32x4 w0 = *(const GAS f32x4*)(L.w0 + c), a0 = *(const GAS f32x4*)(L.a0 + c), k_k = *(const GAS f32x4*)(L.k_k + c), k_a = *(const GAS f32x4*)(L.k_a + c), r_k = *(const GAS f32x4*)(L.r_k + c);
#pragma unroll
            for (int j = 0; j < 4; ++j) {
                const int i = 4 * i4 + j;
                const float x = w0[j] + dw[j];
                const float y = -x; const float sp = fmaxf(y, 0.f) + log1pf(__expf(-fabsf(y)));
                const float wlog = -sp - 0.5f;
                wv[i] = __expf(-__expf(wlog));
                const float a = fsig(a0[j] + da[j]);
                const float kkv = k[j] * k_k[j]; kk[i] = kkv; ss += kkv * kkv;
                const float kpv = k[j] * (1.0f + (a - 1.0f) * k_a[j]); kp[i] = kpv;
                kka[i] = a;
                rr[i] = r[j]; rk += r[j] * kpv * r_k[j]; c3 += r[j] * kpv;
            }
        }
        ss += __shfl_xor(ss, 1); ss += __shfl_xor(ss, 2); rk += __shfl_xor(rk, 1); rk += __shfl_xor(rk, 2);
        const float inv = 1.0f / fmaxf(sqrtf(ss), 1e-12f); float c2 = 0.f;
#pragma unroll
        for (int i = 0; i < 16; ++i) { kk[i] *= inv; kka[i] *= kk[i]; c2 += kka[i] * rr[i]; rr[i] *= wv[i]; }
        c2 += __shfl_xor(c2, 1); c2 += __shfl_xor(c2, 2); c3 += __shfl_xor(c3, 1); c3 += __shfl_xor(c3, 2);
        float* dst = SI + ((size_t)(b * 16 + head) * SEQ + t) * 320 + (lane & 3) * 16;
#pragma unroll
        for (int i4 = 0; i4 < 4; ++i4) {
            *(GAS f32x4*)(dst + 0 * 64 + 4 * i4) = (f32x4){kk[4 * i4], kk[4 * i4 + 1], kk[4 * i4 + 2], kk[4 * i4 + 3]};
            *(GAS f32x4*)(dst + 1 * 64 + 4 * i4) = (f32x4){wv[4 * i4], wv[4 * i4 + 1], wv[4 * i4 + 2], wv[4 * i4 + 3]};
            *(GAS f32x4*)(dst + 2 * 64 + 4 * i4) = (f32x4){kka[4 * i4], kka[4 * i4 + 1], kka[4 * i4 + 2], kka[4 * i4 + 3]};
            *(GAS f32x4*)(dst + 3 * 64 + 4 * i4) = (f32x4){kp[4 * i4], kp[4 * i4 + 1], kp[4 * i4 + 2], kp[4 * i4 + 3]};
            *(GAS f32x4*)(dst + 4 * 64 + 4 * i4) = (f32x4){rr[4 * i4], rr[4 * i4 + 1], rr[4 * i4 + 2], rr[4 * i4 + 3]};
        }
        if ((lane & 3) == 0) { RK[(size_t)m * 16 + head] = rk; *(GAS f32x2v*)(C23 + ((size_t)(b * 16 + head) * SEQ + t) * 2) = (f32x2v){c2, c3}; }
    }
}
__device__ __forceinline__ unsigned f2key(float f) { const unsigned u = __float_as_uint(f); return (u & 0x80000000u) ? ~u : (u | 0x80000000u); }
template <int NS> __device__ __forceinline__ void select_query(const float* srow, u64* mout, const int qc, const int lane) {
    unsigned key[NS];
#pragma unroll
    for (int j = 0; j < NS; ++j) key[j] = __float_as_uint(srow[j * 64 + lane]);
    __builtin_amdgcn_sched_barrier(0);
#pragma unroll
    for (int j = 0; j < NS; ++j) key[j] = (j <= qc) ? f2key(__uint_as_float(key[j])) : 0u;
    unsigned prefix = 0u;
    for (int bit = 31; bit >= 0; --bit) {
        const unsigned cand = prefix | (1u << bit); int cnt = 0;
#pragma unroll
        for (int j = 0; j < NS; ++j) { cnt += __popcll(__ballot(key[j] >= cand)); if ((j & 3) == 3) __builtin_amdgcn_sched_barrier(0); }
        if (cnt >= 256) { prefix = cand; if (cnt == 256) break; }
    }
    u64 mine = 0ull;
#pragma unroll
    for (int j = 0; j < NS; ++j) { const u64 mk = __ballot(key[j] >= prefix); if (lane == j) mine = mk; __builtin_amdgcn_sched_barrier(0); }
    mout[lane] = mine;
}
__device__ __forceinline__ void phase_select(Frame& F) {
    OPAQUE_IDS();
    const float* SC = (const float*)(wsb + WS_SC); u64* MK = (u64*)(wsb + WS_MASK);
    for (int gw = bid * NWAVES + wave; gw < SEQ / 2; gw += G * NWAVES) {
        for (int it = 0; it < 8; ++it) {
            const int b = it >> 1, t = (it & 1) ? (SEQ - 1 - gw) : gw, m = b * SEQ + t, qc = t >> 6;
            u64* mout = MK + (size_t)m * 64;
            if (qc < 4) { mout[lane] = (lane <= qc) ? ~0ull : 0ull; continue; }
            const float* srow = SC + (size_t)m * SEQ;
            if (qc < 16) select_query<16>(srow, mout, qc, lane);
            else if (qc < 32) select_query<32>(srow, mout, qc, lane);
            else if (qc < 48) select_query<48>(srow, mout, qc, lane);
            else select_query<64>(srow, mout, qc, lane);
        }
    }
}
__device__ __forceinline__ void scan_item(Frame& F, unsigned char* wsb, const int item, const int tid_in, const int lane_in, const int wave) {
    int lane_ = lane_in; asm volatile("" : "+v"(lane_)); const int lane = lane_, tid = wave * 64 + lane; (void)tid_in;
    const float* C23 = (const float*)(wsb + WS_C23);
    const float* SI = (const float*)(wsb + WS_SCANIN); const float* RKV = (const float*)(wsb + WS_RKV); float* OBR = (float*)(wsb + WS_OBR);
    LAS float* stg = (LAS float*)(F.lds + RING_OFF);
    LAS float* vst = stg + 2 * 10240;
    LAS float* ost = vst + 2 * 1024;
    LAS float* cst = ost + 2 * 1024;
    {
        const int bh = item >> 1, hf = item & 1, b = bh >> 4, h = bh & 15;
        const float* src = SI + (size_t)bh * SEQ * 320;
        const float* csrc = C23 + (size_t)bh * SEQ * 2;
        const float* vsrc = RKV + (size_t)(b * SEQ) * 3072 + 2048 + h * 64 + hf * 32;
        float* odst = OBR + (size_t)(b * SEQ) * 1024 + h * 64 + hf * 32;
        __syncthreads();
        f32x4 ld[5]; float lv[2], lc = 0.f;
#pragma unroll
        for (int i = 0; i < 5; ++i) ld[i] = *(const GAS f32x4*)(src + (size_t)(tid + 512 * i) * 4);
#pragma unroll
        for (int i = 0; i < 2; ++i) { const int e = tid + 512 * i; lv[i] = vsrc[(size_t)(e >> 5) * 3072 + (e & 31)]; }
        if (tid < 64) lc = csrc[tid];
#pragma unroll
        for (int i = 0; i < 5; ++i) *(LAS f32x4*)(stg + (tid + 512 * i) * 4) = ld[i];
        vst[tid] = lv[0]; vst[tid + 512] = lv[1]; if (tid < 64) cst[tid] = lc;
        __syncthreads();
        float S0 = 0.f, S1 = 0.f, S2 = 0.f, S3 = 0.f;
        const int row = wave * 4 + (lane >> 4), kq = (lane & 15) * 4;
        for (int blk = 0; blk < SEQ / 32; ++blk) {
            const int cb = blk & 1, nb = cb ^ 1;
            if (blk > 0) {
#pragma unroll
                for (int i = 0; i < 2; ++i) { const int e = tid + 512 * i; odst[(size_t)((blk - 1) * 32 + (e >> 5)) * 1024 + (e & 31)] = ost[nb * 1024 + e]; } }
            if (blk + 1 < SEQ / 32) {
#pragma unroll
                for (int i = 0; i < 5; ++i) ld[i] = *(const GAS f32x4*)(src + (size_t)(blk + 1) * 10240 + (size_t)(tid + 512 * i) * 4);
#pragma unroll
                for (int i = 0; i < 2; ++i) { const int e = tid + 512 * i; lv[i] = vsrc[(size_t)((blk + 1) * 32 + (e >> 5)) * 3072 + (e & 31)]; }
                if (tid < 64) lc = csrc[(size_t)(blk + 1) * 64 + tid];
            }
            {
                const LAS float* sb = stg + cb * 10240 + kq; const LAS float* vb = vst + cb * 1024 + row; LAS float* ob = ost + cb * 1024 + row; const LAS float* cb2 = cst + cb * 64;
                f32x4 kk = *(const LAS f32x4*)(sb), w = *(const LAS f32x4*)(sb + 64), ka = *(const LAS f32x4*)(sb + 128), kp = *(const LAS f32x4*)(sb + 192), wr = *(const LAS f32x4*)(sb + 256);
                float v = vb[0]; f32x2v cc = *(const LAS f32x2v*)(cb2);
                for (int g8 = 0; g8 < 4; ++g8) {
                    const LAS float* sg = sb + g8 * (8 * 320); const LAS float* vg8 = vb + g8 * (8 * 32); const LAS float* cg = cb2 + g8 * 16;
                    float ov[8];
#pragma unroll
                    for (int s = 0; s < 8; ++s) {
                        f32x4 nkk = kk, nw = w, nka = ka, nkp = kp, nwr = wr; float nv = v; f32x2v ncc = cc;
                        if (s + 1 < 8 || g8 + 1 < 4) { nkk = *(const LAS f32x4*)(sg + (s + 1) * 320); nw = *(const LAS f32x4*)(sg + (s + 1) * 320 + 64); nka = *(const LAS f32x4*)(sg + (s + 1) * 320 + 128); nkp = *(const LAS f32x4*)(sg + (s + 1) * 320 + 192);
                            nwr = *(const LAS f32x4*)(sg + (s + 1) * 320 + 256); nv = vg8[(s + 1) * 32]; ncc = *(const LAS f32x2v*)(cg + 2 * (s + 1)); }
                        float sa = vfma(S1, kk.y, vmul(S0, kk.x)) + vfma(S3, kk.w, vmul(S2, kk.z));
                        float p1 = vfma(S1, wr.y, vmul(S0, wr.x)) + vfma(S3, wr.w, vmul(S2, wr.z));
                        sa += dppf<0xB1>(sa); p1 += dppf<0xB1>(p1); sa += dppf<0x4E>(sa); p1 += dppf<0x4E>(p1); sa += dppf<0x124>(sa); p1 += dppf<0x124>(p1); sa += dppf<0x128>(sa); p1 += dppf<0x128>(p1);
                        S0 = vfma(S0, w.x, vfnma(sa, ka.x, vmul(kp.x, v))); S1 = vfma(S1, w.y, vfnma(sa, ka.y, vmul(kp.y, v))); S2 = vfma(S2, w.z, vfnma(sa, ka.z, vmul(kp.z, v))); S3 = vfma(S3, w.w, vfnma(sa, ka.w, vmul(kp.w, v)));
                        ov[s] = vfma(v, cc.y, vfnma(sa, cc.x, p1));
#if defined(SCAN_XDPP)
                        { float d_ = p1; d_ += dppf<0xB1>(d_); d_ += dppf<0x4E>(d_); d_ += dppf<0x124>(d_); d_ += dppf<0x128>(d_); d_ += dppf<0xB1>(d_); d_ += dppf<0x4E>(d_); d_ += dppf<0x124>(d_); d_ += dppf<0x128>(d_); asm volatile("" :: "v"(d_)); }
#endif
#if defined(SCAN_XLDS)
                        { const f32x4 x0_ = *(const volatile LAS f32x4*)(sg + s * 320), x1_ = *(const volatile LAS f32x4*)(sg + s * 320 + 64), x2_ = *(const volatile LAS f32x4*)(sg + s * 320 + 128), x3_ = *(const volatile LAS f32x4*)(sg + s * 320 + 192), x4_ = *(const volatile LAS f32x4*)(sg + s * 320 + 256);
                          asm volatile("" :: "v"(x0_), "v"(x1_), "v"(x2_), "v"(x3_), "v"(x4_)); }
#endif
#if defined(SCAN_XVALU)
                        { float d_ = p1;
#pragma unroll
                          for (int q_ = 0; q_ < 30; ++q_) { d_ = d_ * 1.0001f + 0.5f; asm volatile("" : "+v"(d_)); }
                          asm volatile("" :: "v"(d_)); }
#endif
                        kk = nkk; w = nw; ka = nka; kp = nkp; wr = nwr; v = nv; cc = ncc;
                        __builtin_amdgcn_sched_barrier(0);
                    }
                    if ((lane & 15) == 0) {
#pragma unroll
                        for (int s = 0; s < 8; ++s) ob[(g8 * 8 + s) * 32] = ov[s]; }
                }
            }
            if (blk + 1 < SEQ / 32) {
#pragma unroll
                for (int i = 0; i < 5; ++i) *(LAS f32x4*)(stg + nb * 10240 + (tid + 512 * i) * 4) = ld[i];
                vst[nb * 1024 + tid] = lv[0]; vst[nb * 1024 + tid + 512] = lv[1]; if (tid < 64) cst[nb * 64 + tid] = lc;
            }
            __syncthreads();
        }
#pragma unroll
        for (int i = 0; i < 2; ++i) { const int e = tid + 512 * i; odst[(size_t)((SEQ / 32 - 1) * 32 + (e >> 5)) * 1024 + (e & 31)] = ost[((SEQ / 32 - 1) & 1) * 1024 + e]; }
    }
    __syncthreads();
}
__device__ __forceinline__ bf16x8 pack8(const float (&v)[8]) {
    v4u o; o.x = pkbf(v[0], v[1]); o.y = pkbf(v[2], v[3]); o.z = pkbf(v[4], v[5]); o.w = pkbf(v[6], v[7]); return __builtin_bit_cast(bf16x8, o);
}
__device__ __forceinline__ void hgrn_item(Frame& F, unsigned char* wsb, const LayerIn& L, const int layer, const int item, const int tid_in, const int lane_in, const int wave) {
    int lane_ = lane_in; asm volatile("" : "+v"(lane_));
    const int lane = lane_, tid = wave * 64 + lane; (void)tid_in;
    const int fr = lane & 15, fq = lane >> 4;
    const bf16* PA = (const bf16*)(wsb + WS_PA); const float* PAF = (const float*)(wsb + WS_PAF); float* OAR = (float*)(wsb + WS_OAR);
    constexpr int NV = 4;
    LAS bf16* AJ = (LAS bf16*)(F.lds + 0);
    LAS float* ET = (LAS float*)(F.lds + 17408);
    LAS bf16* QT = (LAS bf16*)(F.lds + 24576);
    LAS bf16* IT = (LAS bf16*)(F.lds + 41984);
    LAS bf16* ST = (LAS bf16*)(F.lds + 51200);
    LAS float* TOT = (LAS float*)(F.lds + 120832);
    LAS float* RR = (LAS float*)(F.lds + 122880);
    {
        const int b = item >> 4, h = (item >> 1) & 7, js = item & 1;
        const int k = tid & 127, I = tid >> 7;
        float lb = 0.f;
        if (layer == 1) lb = fsig(L.lb1[h * 128 + k] - L.lb0[h * 128 + k]);
        const float omlb = 1.0f - lb;
        f32x4 st[NV];
#pragma unroll
        for (int vb = 0; vb < NV; ++vb) st[vb] = (f32x4){0.f, 0.f, 0.f, 0.f};
        unsigned qreg[16], ireg[2 * NV]; float zreg[16];
        const unsigned qoff = (unsigned)((16 * I) * LDPA + h * 128 + k), foff = (unsigned)((16 * I) * 1024 + h * 128 + k);
        const unsigned ioff0 = (unsigned)((tid >> 6) * LDPA + 2048 + h * 128 + js * 64 + (tid & 63));
        { const bf16* pc = PA + (size_t)(b * SEQ) * LDPA; const float* fc = PAF + (size_t)(b * SEQ) * 1024;
#pragma unroll
          for (int tt = 0; tt < 16; ++tt) { qreg[tt] = pc[qoff + (unsigned)(tt * LDPA)]; zreg[tt] = fc[foff + (unsigned)(tt * 1024)]; }
#pragma unroll
          for (int r = 0; r < 2 * NV; ++r) ireg[r] = pc[ioff0 + (unsigned)(8 * r * LDPA)]; }
        for (int c = 0; c < SEQ / 64; ++c) {
            const int m0 = b * SEQ + c * 64;
            __syncthreads();
            { float cl = 0.f;
#pragma unroll
              for (int tt = 0; tt < 16; ++tt) {
                  if ((tt & 3) == 0) __builtin_amdgcn_sched_barrier(0);
                  const int t = 16 * I + tt;
                  const float qv = __uint_as_float(qreg[tt] << 16), z = zreg[tt];
                  const float ez = __expf(-fminf(fmaxf(z, -80.f), 80.f));
                  const float sig = __builtin_amdgcn_rcpf(1.0f + ez);
                  const float f = lb + omlb * sig;
                  cl += __logf(f);
                  const float kin = omlb * (ez * sig);
                  const float qf = qv * __builtin_amdgcn_rcpf(1.0f + __expf(-qv));
                  QT[t * 136 + k] = (bf16)(pkbf(qf * __expf(cl), 0.f) & 0xffffu);
                  AJ[t * 136 + k] = (bf16)(pkbf(kin * __expf(fminf(-cl, 80.f)), 0.f) & 0xffffu);
              }
              TOT[I * 128 + k] = cl; }
#pragma unroll
            for (int r = 0; r < 2 * NV; ++r) { const int e = tid + 512 * r, t = e >> 6, v = e & 63; IT[v * 72 + t] = (bf16)ireg[r]; }
            if (c + 1 < SEQ / 64) {
                const bf16* pc = PA + (size_t)(m0 + 64) * LDPA; const float* fc = PAF + (size_t)(m0 + 64) * 1024;
#pragma unroll
                for (int tt = 0; tt < 16; ++tt) { qreg[tt] = pc[qoff + (unsigned)(tt * LDPA)]; zreg[tt] = fc[foff + (unsigned)(tt * 1024)]; }
#pragma unroll
                for (int r = 0; r < 2 * NV; ++r) ireg[r] = pc[ioff0 + (unsigned)(8 * r * LDPA)];
            }
            __syncthreads();
            if (tid < 128) { const float t0 = TOT[tid], t1 = TOT[128 + tid], t2 = TOT[256 + tid], t3 = TOT[384 + tid];
                const float R1 = t0, R2 = t0 + t1, R3 = R2 + t2, R4 = R3 + t3;
                RR[tid] = 0.f; RR[128 + tid] = R1; RR[256 + tid] = R2; RR[384 + tid] = R3; RR[512 + tid] = R4;
                const float Rv[5] = {0.f, R1, R2, R3, R4};
#pragma unroll
                for (int Ii = 0; Ii < 5; ++Ii)
#pragma unroll
                    for (int J = 0; J < 4; ++J) if (J <= Ii) { const int idx = (Ii < 4) ? Ii * (Ii + 1) / 2 + J : 10 + J; ET[idx * 128 + tid] = __expf(Rv[Ii] - Rv[J]); } }
            __syncthreads();
            { const int kk = 16 * wave + fr;
#pragma unroll
              for (int Ib = 0; Ib < 4; ++Ib) { const float e = __expf(RR[Ib * 128 + kk]);
#pragma unroll
                  for (int vb = 0; vb < NV; ++vb)
#pragma unroll
                      for (int j = 0; j < 4; ++j) ST[(Ib * 16 * NV + vb * 16 + 4 * fq + j) * 136 + kk] = (bf16)(pkbf(st[vb][j] * e, 0.f) & 0xffffu); } }
            __syncthreads();
            if (wave < 4) {
                const int Iw = wave;
                bf16x8 qb[4];
#pragma unroll
                for (int ks = 0; ks < 4; ++ks) qb[ks] = *(const LAS bf16x8*)(QT + (16 * Iw + fr) * 136 + 32 * ks + 8 * fq);
                f32x4 at[4];
#pragma unroll
                for (int J = 0; J < 4; ++J) { at[J] = (f32x4){0.f, 0.f, 0.f, 0.f};
                    if (J <= Iw) {
#pragma unroll
                        for (int ks = 0; ks < 4; ++ks) {
                            const int s = 16 * J + fr, k0 = 32 * ks + 8 * fq; float a[8];
                            const int eidx = Iw * (Iw + 1) / 2 + J;
                            const v4u ajw = *(const LAS v4u*)(AJ + s * 136 + k0);
                            const f32x4 e0 = *(const LAS f32x4*)(ET + eidx * 128 + k0), e1 = *(const LAS f32x4*)(ET + eidx * 128 + k0 + 4);
                            a[0] = __uint_as_float(ajw.x << 16) * e0[0]; a[1] = __uint_as_float(ajw.x & 0xffff0000u) * e0[1]; a[2] = __uint_as_float(ajw.y << 16) * e0[2]; a[3] = __uint_as_float(ajw.y & 0xffff0000u) * e0[3];
                            a[4] = __uint_as_float(ajw.z << 16) * e1[0]; a[5] = __uint_as_float(ajw.z & 0xffff0000u) * e1[1]; a[6] = __uint_as_float(ajw.w << 16) * e1[2]; a[7] = __uint_as_float(ajw.w & 0xffff0000u) * e1[3];
                            at[J] = __builtin_amdgcn_mfma_f32_16x16x32_bf16(pack8(a), qb[ks], at[J], 0, 0, 0);
                        }
                        if (J == Iw) {
#pragma unroll
                            for (int j = 0; j < 4; ++j) if (4 * fq + j > fr) at[J][j] = 0.f; }
                    } }
                f32x4 oacc[NV];
#pragma unroll
                for (int vb = 0; vb < NV; ++vb) oacc[vb] = (f32x4){0.f, 0.f, 0.f, 0.f};
#pragma unroll
                for (int vb = 0; vb < NV; ++vb)
#pragma unroll
                    for (int ks = 0; ks < 4; ++ks) { const bf16x8 sa = *(const LAS bf16x8*)(ST + (Iw * 16 * NV + vb * 16 + fr) * 136 + 32 * ks + 8 * fq);
                        oacc[vb] = __builtin_amdgcn_mfma_f32_16x16x32_bf16(sa, qb[ks], oacc[vb], 0, 0, 0); if (ks == 3) __builtin_amdgcn_sched_barrier(0); }
#pragma unroll
                for (int p = 0; p < 2; ++p) if (2 * p <= Iw) {
                    float pv[8];
#pragma unroll
                    for (int j = 0; j < 4; ++j) { pv[j] = at[2 * p][j]; pv[4 + j] = at[2 * p + 1][j]; }
                    const bf16x8 pb = pack8(pv);
#pragma unroll
                    for (int vb = 0; vb < NV; ++vb) {
                        const u32x2v i0 = *(const LAS u32x2v*)(IT + (vb * 16 + fr) * 72 + 32 * p + 4 * fq), i1 = *(const LAS u32x2v*)(IT + (vb * 16 + fr) * 72 + 32 * p + 16 + 4 * fq);
                        v4u ia; ia.x = i0.x; ia.y = i0.y; ia.z = i1.x; ia.w = i1.y;
                        oacc[vb] = __builtin_amdgcn_mfma_f32_16x16x32_bf16(__builtin_bit_cast(bf16x8, ia), pb, oacc[vb], 0, 0, 0); __builtin_amdgcn_sched_barrier(0); }
                }
#pragma unroll
                for (int vb = 0; vb < NV; ++vb) *(GAS f32x4*)(OAR + (size_t)(m0 + 16 * Iw + fr) * 1024 + h * 128 + js * 64 + vb * 16 + 4 * fq) = oacc[vb];
            }
            { const int kk = 16 * wave + fr; const float r4 = RR[512 + kk]; const float e4 = __expf(r4);
#pragma unroll
              for (int vb = 0; vb < NV; ++vb) st[vb] = st[vb] * e4;
#pragma unroll
              for (int ks = 0; ks < 2; ++ks) {
                  const int J = 2 * ks + (fq >> 1); const float ej = ET[(10 + J) * 128 + kk]; float kb[8];
#pragma unroll
                  for (int j = 0; j < 8; ++j) { const int s = 32 * ks + 8 * fq + j; kb[j] = bf2f(AJ[s * 136 + kk]) * ej; }
                  const bf16x8 kbp = pack8(kb);
#pragma unroll
                  for (int vb = 0; vb < NV; ++vb) { const bf16x8 ia = *(const LAS bf16x8*)(IT + (vb * 16 + fr) * 72 + 32 * ks + 8 * fq);
                      st[vb] = __builtin_amdgcn_mfma_f32_16x16x32_bf16(ia, kbp, st[vb], 0, 0, 0); __builtin_amdgcn_sched_barrier(0); }
              } }
        }
    }
    __syncthreads();
}

__device__ __forceinline__ void phase_scan_hgrn(Frame& F, const LayerIn& L, const int layer, const int do_scan, const int do_hgrn) {
    OPAQUE_IDS();
    for (int it = bid; it < 192; it += G) {
        if (it < 128) { if (do_scan) scan_item(F, wsb, it, tid, lane, wave); }
        else { if (do_hgrn) hgrn_item(F, wsb, L, layer, it - 128, tid, lane, wave); }
    }
}
__device__ __forceinline__ void phase_attn(Frame& F, const int layer, const float* qgain, const float* kgain) {
    OPAQUE_IDS();
    float negm0;
    { float gq = fmaxf(fabsf(qgain[lane]), fabsf(qgain[lane + 64])), gk = fmaxf(fabsf(kgain[lane]), fabsf(kgain[lane + 64]));
#pragma unroll
      for (int o = 1; o < 64; o <<= 1) { gq = fmaxf(gq, __shfl_xor(gq, o)); gk = fmaxf(gk, __shfl_xor(gk, o)); }
      negm0 = -fmaxf(0.0f, 16.5f * gq * gk - 60.0f); }
    const int fr = lane & 15, fq = lane >> 4;
    const bf16* QC = (const bf16*)(wsb + WS_QC); const bf16* KC = (const bf16*)(wsb + WS_KC); const bf16* VT = (const bf16*)(wsb + WS_VT); const u64* MK = (const u64*)(wsb + WS_MASK);
    bf16* OC = (bf16*)(wsb + WS_OC);
    LAS bf16* KS = (LAS bf16*)(F.lds + 0);
    LAS bf16* VS = (LAS bf16*)(F.lds + 2 * 17408);
    gu32* qhead = F.ctl + CW_QUEUE + 64 * layer;
    LAS unsigned* qslot = (LAS unsigned*)(F.lds + LDSCTL_OFF + 64);
    {
        for (;;) {
            if (tid == 0) *qslot = __hip_atomic_fetch_add(qhead, 1u, __ATOMIC_RELAXED, __HIP_MEMORY_SCOPE_AGENT);
            __syncthreads();
            const unsigned u = *qslot;
            if (u >= 1024u) break;
            const int qc = 63 - (int)(u >> 4), combo = (int)(u & 15u), b = combo >> 2, g = combo & 3;
            const int hq = g * 4 + (wave >> 1), tq0 = qc * 64 + (wave & 1) * 32;
            bf16x8 Qf[2][4];
#pragma unroll
            for (int qb = 0; qb < 2; ++qb)
#pragma unroll
                for (int ks = 0; ks < 4; ++ks) Qf[qb][ks] = *(const GAS bf16x8*)(QC + (size_t)(b * SEQ + tq0 + qb * 16 + fr) * 2048 + hq * 128 + 32 * ks + 8 * fq);
            f32x4 O[8][2];
#pragma unroll
            for (int db = 0; db < 8; ++db) { O[db][0] = (f32x4){0.f, 0.f, 0.f, 0.f}; O[db][1] = (f32x4){0.f, 0.f, 0.f, 0.f}; }
            float lrow[2] = {0.f, 0.f};
            v4u sregK[2], sregV[2];
            const char* kg = (const char*)(KC + (size_t)(b * SEQ) * 512 + g * 128); const char* vg = (const char*)(VT + (size_t)((b * 4 + g) * 128) * SEQ);
            unsigned kgo[2], vgo[2], klo[2], vlo[2];
#pragma unroll
            for (int i = 0; i < 2; ++i) { const int c = tid + 512 * i; kgo[i] = (unsigned)(((c >> 4) * 512 + (c & 15) * 8) * 2); vgo[i] = (unsigned)(((c >> 3) * SEQ + (c & 7) * 8) * 2);
                klo[i] = (unsigned)(((c >> 4) * 136 + (c & 15) * 8) * 2); vlo[i] = (unsigned)(2 * 17408 + ((c >> 3) * 72 + (c & 7) * 8) * 2); }
            __syncthreads();
#pragma unroll
            for (int i = 0; i < 2; ++i) sregK[i] = *(const GAS v4u*)(kg + kgo[i]);
#pragma unroll
            for (int i = 0; i < 2; ++i) sregV[i] = *(const GAS v4u*)(vg + vgo[i]);
#pragma unroll
            for (int i = 0; i < 2; ++i) *(LAS v4u*)(F.lds + klo[i]) = sregK[i];
#pragma unroll
            for (int i = 0; i < 2; ++i) *(LAS v4u*)(F.lds + vlo[i]) = sregV[i];
            if (qc >= 1) {
#pragma unroll
                for (int i = 0; i < 2; ++i) sregK[i] = *(const GAS v4u*)(kg + (size_t)(64 * 512 * 2) + kgo[i]);
#pragma unroll
                for (int i = 0; i < 2; ++i) sregV[i] = *(const GAS v4u*)(vg + (size_t)(64 * 2) + vgo[i]);
            }
            const u64* mkb = MK + (size_t)(b * SEQ) * 64; const unsigned mko0 = (unsigned)((tq0 + fr) * 64), mko1 = mko0 + 16 * 64;
            u64 mn0 = mkb[mko0], mn1 = mkb[mko1];
            __syncthreads();
#define ATT_RDK(ks_, i_) (*(const LAS bf16x8*)((ks_) + (16 * ((i_) >> 2) + fr) * 136 + 32 * ((i_) & 3) + 8 * fq))
#define ATT_S(Sd, ks_) do { bf16x8 rg_[4]; rg_[0] = ATT_RDK(ks_, 0); rg_[1] = ATT_RDK(ks_, 1); rg_[2] = ATT_RDK(ks_, 2); const f32x4 ini_ = (f32x4){negm0, negm0, negm0, negm0}; \
                _Pragma("unroll") for (int i = 0; i < 16; ++i) { if (i + 3 < 16) rg_[(i + 3) & 3] = ATT_RDK(ks_, i + 3); \
                    __builtin_amdgcn_sched_barrier(0); \
                    Sd[i >> 2][0] = __builtin_amdgcn_mfma_f32_16x16x32_bf16(rg_[i & 3], Qf[0][i & 3], (i & 3) ? Sd[i >> 2][0] : ini_, 0, 0, 0); \
                    Sd[i >> 2][1] = __builtin_amdgcn_mfma_f32_16x16x32_bf16(rg_[i & 3], Qf[1][i & 3], (i & 3) ? Sd[i >> 2][1] : ini_, 0, 0, 0); \
                    __builtin_amdgcn_sched_barrier(0); } } while (0)
#define ATT_SM(Sd, mw0_, mw1_, Pd) do { \
                _Pragma("unroll") for (int qb = 0; qb < 2; ++qb) { const u64 mwq = (qb == 0) ? (mw0_) : (mw1_); const unsigned mlo = (unsigned)mwq, mhi = (unsigned)(mwq >> 32); \
                    float ps = 0.f; float p[4][4]; \
                    _Pragma("unroll") for (int kb = 0; kb < 4; ++kb) _Pragma("unroll") for (int j = 0; j < 4; ++j) { unsigned keep_; asm("v_bfe_i32 %0, %1, %2, 1" : "=v"(keep_) : "v"((kb < 2) ? mlo : mhi), "n"(16 * (kb & 1) + j)); \
                        p[kb][j] = __builtin_bit_cast(float, __builtin_bit_cast(unsigned, __builtin_amdgcn_exp2f(Sd[kb][qb][j])) & (unsigned)keep_); ps += p[kb][j]; } \
                    lrow[qb] += ps; \
                    _Pragma("unroll") for (int pp = 0; pp < 2; ++pp) { v4u o_; o_.x = pkbf(p[2 * pp][0], p[2 * pp][1]); o_.y = pkbf(p[2 * pp][2], p[2 * pp][3]); o_.z = pkbf(p[2 * pp + 1][0], p[2 * pp + 1][1]); o_.w = pkbf(p[2 * pp + 1][2], p[2 * pp + 1][3]); \
                        Pd[qb][pp] = __builtin_bit_cast(bf16x8, o_); } } } while (0)
#define ATT_RDV(vs_, i_, h_) (*(const LAS u32x2v*)((vs_) + (16 * ((i_) >> 1) + fr) * 72 + 32 * ((i_) & 1) + 16 * (h_) + 4 * fq))
#define ATT_LDV(vs_, i_, d_) do { const u32x2v v0_ = ATT_RDV(vs_, i_, 0), v1_ = ATT_RDV(vs_, i_, 1); v4u va_; va_.x = v0_.x; va_.y = v0_.y; va_.z = v1_.x; va_.w = v1_.y; d_ = __builtin_bit_cast(bf16x8, va_); } while (0)
#define ATT_PV(Pd, vs_) do { bf16x8 rg_[4]; ATT_LDV(vs_, 0, rg_[0]); ATT_LDV(vs_, 1, rg_[1]); ATT_LDV(vs_, 2, rg_[2]); \
                _Pragma("unroll") for (int i = 0; i < 16; ++i) { if (i + 3 < 16) ATT_LDV(vs_, i + 3, rg_[(i + 3) & 3]); \
                    __builtin_amdgcn_sched_barrier(0); \
                    O[i >> 1][0] = __builtin_amdgcn_mfma_f32_16x16x32_bf16(rg_[i & 3], Pd[0][i & 1], O[i >> 1][0], 0, 0, 0); \
                    O[i >> 1][1] = __builtin_amdgcn_mfma_f32_16x16x32_bf16(rg_[i & 3], Pd[1][i & 1], O[i >> 1][1], 0, 0, 0); \
                    __builtin_amdgcn_sched_barrier(0); } } while (0)
            const bool early = wave < 4;
            bf16x8 Pf[2][2];
            int vcur = 0, vprev = 0;
            for (int kt = 0; kt <= qc; ++kt) {
                const int cb = kt & 1, nb = cb ^ 1; const int vnext = (vcur == 2) ? 0 : vcur + 1;
                const u64 mc0 = mn0 >> (4 * fq), mc1 = mn1 >> (4 * fq);
                if (kt < qc) {
#pragma unroll
                    for (int i = 0; i < 2; ++i) *(LAS v4u*)(F.lds + nb * (64 * 136 * 2) + klo[i]) = sregK[i];
#pragma unroll
                    for (int i = 0; i < 2; ++i) *(LAS v4u*)(F.lds + vnext * (128 * 72 * 2) + vlo[i]) = sregV[i];
                    mn0 = mkb[mko0 + kt + 1]; mn1 = mkb[mko1 + kt + 1];
                }
                if (kt + 1 < qc) {
#pragma unroll
                    for (int i = 0; i < 2; ++i) sregK[i] = *(const GAS v4u*)(kg + (size_t)(kt + 2) * (64 * 512 * 2) + kgo[i]);
#pragma unroll
                    for (int i = 0; i < 2; ++i) sregV[i] = *(const GAS v4u*)(vg + (size_t)(kt + 2) * (64 * 2) + vgo[i]);
                }
                const LAS bf16* ks_ = KS + cb * (64 * 136);
                f32x4 S[4][2];
                if (!early && kt > 0) { ATT_PV(Pf, VS + vprev * (128 * 72)); }
                ATT_S(S, ks_);
                ATT_SM(S, mc0, mc1, Pf);
                if (early) { ATT_PV(Pf, VS + vcur * (128 * 72)); }
                vprev = vcur; vcur = vnext;
                __syncthreads();
            }
            if (!early) { ATT_PV(Pf, VS + vprev * (128 * 72)); }
#undef ATT_S
#undef ATT_SM
#undef ATT_PV
#undef ATT_RDK
#undef ATT_RDV
#undef ATT_LDV
#pragma unroll
            for (int qb = 0; qb < 2; ++qb) {
                float l = lrow[qb]; l += __shfl_xor(l, 16); l += __shfl_xor(l, 32);
                const float inv = 1.0f / l;
                bf16* orow = OC + (size_t)(b * SEQ + tq0 + qb * 16 + fr) * 2048 + hq * 128 + 4 * fq;
#pragma unroll
                for (int db = 0; db < 8; ++db) { u32x2v w; w.x = pkbf(O[db][qb][0] * inv, O[db][qb][1] * inv); w.y = pkbf(O[db][qb][2] * inv, O[db][qb][3] * inv); *(GAS u32x2v*)(orow + 16 * db) = w; }
            }
        }
    }
    __syncthreads();
}
__device__ __forceinline__ void phase_post(Frame& F, const LayerIn& L) {
    OPAQUE_IDS();
    const int gw = bid * NWAVES + wave, NGW = G * NWAVES;
    const float* OAR = (const float*)(wsb + WS_OAR); const float* OBR = (const float*)(wsb + WS_OBR); const bf16* PA = (const bf16*)(wsb + WS_PA);
    const float* RKV = (const float*)(wsb + WS_RKV); const bf16* LO = (const bf16*)(wsb + WS_LO); const float* RK = (const float*)(wsb + WS_RK);
    bf16* OA = (bf16*)(wsb + WS_OA); bf16* OB = (bf16*)(wsb + WS_OB);
    for (int m = gw; m < M; m += NGW) {
        const int c0 = lane * 16;
        { float o[16]; float ss = 0.f;
#pragma unroll
          for (int i = 0; i < 4; ++i) { const f32x4 v = *(const GAS f32x4*)(OAR + (size_t)m * 1024 + c0 + 4 * i); o[4 * i] = v.x; o[4 * i + 1] = v.y; o[4 * i + 2] = v.z; o[4 * i + 3] = v.w; ss += (v.x * v.x + v.y * v.y) + (v.z * v.z + v.w * v.w); }
          ss += __shfl_xor(ss, 1); ss += __shfl_xor(ss, 2); ss += __shfl_xor(ss, 4);
          const float rinv = 1.0f / sqrtf(ss * (1.0f / 128.0f) + NORM_EPS);
          float y[16];
#pragma unroll
          for (int i = 0; i < 4; ++i) { const f32x4 gn = *(const GAS f32x4*)(L.out_norm + (lane & 7) * 16 + 4 * i), gg = bf4_to_f32(*(const GAS u32x2v*)(PA + (size_t)m * LDPA + 3072 + c0 + 4 * i));
#pragma unroll
              for (int j = 0; j < 4; ++j) { const float g = gg[j]; y[4 * i + j] = o[4 * i + j] * rinv * gn[j] * (g / (1.0f + __expf(-g))); } }
#pragma unroll
          for (int i = 0; i < 2; ++i) { v4u w; w.x = pkbf(y[8 * i], y[8 * i + 1]); w.y = pkbf(y[8 * i + 2], y[8 * i + 3]); w.z = pkbf(y[8 * i + 4], y[8 * i + 5]); w.w = pkbf(y[8 * i + 6], y[8 * i + 7]);
              *(GAS v4u*)(OA + (size_t)m * 2048 + c0 + 8 * i) = w; } }
        { float o[16]; float s1 = 0.f;
#pragma unroll
          for (int i = 0; i < 4; ++i) { const f32x4 v = *(const GAS f32x4*)(OBR + (size_t)m * 1024 + c0 + 4 * i); o[4 * i] = v.x; o[4 * i + 1] = v.y; o[4 * i + 2] = v.z; o[4 * i + 3] = v.w; s1 += (v.x + v.y) + (v.z + v.w); }
          s1 += __shfl_xor(s1, 1); s1 += __shfl_xor(s1, 2);
          const float mean = s1 * (1.0f / 64.0f); float s2 = 0.f;
#pragma unroll
          for (int i = 0; i < 16; ++i) { o[i] -= mean; s2 += o[i] * o[i]; }
          s2 += __shfl_xor(s2, 1); s2 += __shfl_xor(s2, 2);
          const float rstd = 1.0f / sqrtf(s2 * (1.0f / 64.0f) + 64e-5f);
          const float rk = RK[(size_t)m * 16 + (lane >> 2)];
          float y[16];
#pragma unroll
          for (int i = 0; i < 4; ++i) { const f32x4 lw = *(const GAS f32x4*)(L.ln_w + c0 + 4 * i), lbv = *(const GAS f32x4*)(L.ln_b + c0 + 4 * i);
              const f32x4 vv = *(const GAS f32x4*)(RKV + (size_t)m * 3072 + 2048 + c0 + 4 * i), gg = bf4_to_f32(*(const GAS u32x2v*)(LO + (size_t)m * 3072 + 2048 + c0 + 4 * i));
#pragma unroll
              for (int j = 0; j < 4; ++j) y[4 * i + j] = (o[4 * i + j] * rstd * lw[j] + lbv[j] + rk * vv[j]) * gg[j]; }
#pragma unroll
          for (int i = 0; i < 2; ++i) { v4u w; w.x = pkbf(y[8 * i], y[8 * i + 1]); w.y = pkbf(y[8 * i + 2], y[8 * i + 3]); w.z = pkbf(y[8 * i + 4], y[8 * i + 5]); w.w = pkbf(y[8 * i + 6], y[8 * i + 7]);
              *(GAS v4u*)(OB + (size_t)m * 2048 + c0 + 8 * i) = w; } }
    }
}
__device__ __forceinline__ void phase_convfix(Frame& F, const LayerIn& L) {
    OPAQUE_IDS();
    const int gw = bid * NWAVES + wave, NGW = G * NWAVES;
    const float* HF = (const float*)(wsb + WS_HALOF); const float* HL = (const float*)(wsb + WS_HALOL); bf16* ACT = (bf16*)(wsb + WS_ACT);
    constexpr int NSTRIP = DFF / 256;
    for (int it = gw; it < NSTRIP * 256; it += NGW) {
        const int sp = it % NSTRIP, blk = it / NSTRIP, c = sp * 256 + lane * 4; const bool hp = (blk % 64) != 0;
        f32x4 wg[3], wu[3];
#pragma unroll
        for (int j = 0; j < 3; ++j) { wg[j] = *(const GAS f32x4*)(L.conv_w + (size_t)j * NUP + c); wu[j] = *(const GAS f32x4*)(L.conv_w + (size_t)j * NUP + DFF + c); }
        const f32x4 bg = *(const GAS f32x4*)(L.conv_b + c), bu = *(const GAS f32x4*)(L.conv_b + DFF + c);
        const f32x4 z = (f32x4){0.f, 0.f, 0.f, 0.f};
        const float* f0 = HF + (size_t)(blk * 2) * NUP; const float* l0 = HL + (size_t)((hp ? blk - 1 : blk) * 2) * NUP;
        const f32x4 g_m2 = hp ? *(const GAS f32x4*)(l0 + c) : z, g_m1 = hp ? *(const GAS f32x4*)(l0 + NUP + c) : z, g_0 = *(const GAS f32x4*)(f0 + c), g_1 = *(const GAS f32x4*)(f0 + NUP + c);
        const f32x4 u_m2 = hp ? *(const GAS f32x4*)(l0 + DFF + c) : z, u_m1 = hp ? *(const GAS f32x4*)(l0 + NUP + DFF + c) : z, u_0 = *(const GAS f32x4*)(f0 + DFF + c), u_1 = *(const GAS f32x4*)(f0 + NUP + DFF + c);
        const f32x4 gc0 = wg[0] * g_m2 + wg[1] * g_m1 + wg[2] * g_0 + bg, uc0 = wu[0] * u_m2 + wu[1] * u_m1 + wu[2] * u_0 + bu;
        const f32x4 gc1 = wg[0] * g_m1 + wg[1] * g_0 + wg[2] * g_1 + bg, uc1 = wu[0] * u_m1 + wu[1] * u_0 + wu[2] * u_1 + bu;
        f32x4 a0, a1;
#pragma unroll
        for (int j = 0; j < 4; ++j) { a0[j] = (gc0[j] / (1.0f + __expf(-gc0[j]))) * uc0[j]; a1[j] = (gc1[j] / (1.0f + __expf(-gc1[j]))) * uc1[j]; }
        u32x2v w0, w1; w0.x = pkbf(a0[0], a0[1]); w0.y = pkbf(a0[2], a0[3]); w1.x = pkbf(a1[0], a1[1]); w1.y = pkbf(a1[2], a1[3]);
        *(GAS u32x2v*)(ACT + (size_t)(blk * 64) * DFF + c) = w0; *(GAS u32x2v*)(ACT + (size_t)(blk * 64 + 1) * DFF + c) = w1;
    }
}
__device__ __forceinline__ void phase_tailfix(Frame& F, const pg8::EpiConvAct& E, const pg8::SplitTailOrder& S, const float* part) {
    OPAQUE_IDS();
    const int half = G >> 1;
    if (S.split() && bid < half) {
        pg8::Unit u; S.next(S.nwg / G, u);
        const int wr = wave >> 2, wc = wave & 3, fr = lane & 15, fq = lane >> 4;
        const f32x4* p0 = (const f32x4*)part + (size_t)bid * (32 * 512) + tid; const f32x4* p1 = p0 + (size_t)half * (32 * 512);
        constexpr int NUPc = 22016, DFFc = 11008;
        const int row0 = u.pm * 256 + wr * 64 + fr, ch0 = u.pn * 128 + wc * 32 + 8 * fq;
        const int l1 = fq * 16 + ((fr + 15) & 15), l2 = fq * 16 + ((fr + 14) & 15);
#pragma unroll
        for (int n = 0; n < 2; ++n) {
            const int ch = ch0 + 4 * n;
            const f32x4 wg0 = *(const f32x4*)(E.cw + ch), wg1 = *(const f32x4*)(E.cw + NUPc + ch), wg2 = *(const f32x4*)(E.cw + 2 * NUPc + ch), bg = *(const f32x4*)(E.cb + ch);
            const f32x4 wu0 = *(const f32x4*)(E.cw + DFFc + ch), wu1 = *(const f32x4*)(E.cw + NUPc + DFFc + ch), wu2 = *(const f32x4*)(E.cw + 2 * NUPc + DFFc + ch), bu = *(const f32x4*)(E.cb + DFFc + ch);
#pragma unroll
            for (int ai = 0; ai < 2; ++ai) {
                const int blk = u.pm * 4 + ai * 2 + wr;
                f32x4 ag[4], au[4];
#pragma unroll
                for (int m = 0; m < 4; ++m) { const int ig = (((ai * 2 + 0) * 4 + m) * 2 + n) * 512, iu = (((ai * 2 + 1) * 4 + m) * 2 + n) * 512; ag[m] = p0[ig] + p1[ig]; au[m] = p0[iu] + p1[iu]; }
                f32x4 q1g = (f32x4){0.f, 0.f, 0.f, 0.f}, q2g = q1g, q1u = q1g, q2u = q1g;
#pragma unroll
                for (int m = 0; m < 4; ++m) {
                    const int row = row0 + ai * 128 + m * 16;
                    const float sc = 1.0f / __builtin_sqrtf(E.rs[row] * (1.0f / 4096.0f) + 1e-6f);
                    const f32x4 xg = ag[m] * sc, xu = au[m] * sc;
                    const f32x4 p1g = pg8::shf4(xg, l1), p2g = pg8::shf4(xg, l2), p1u = pg8::shf4(xu, l1), p2u = pg8::shf4(xu, l2);
                    const f32x4 g1 = (fr == 0) ? q1g : p1g, g2 = (fr < 2) ? q2g : p2g, u1 = (fr == 0) ? q1u : p1u, u2 = (fr < 2) ? q2u : p2u;
                    const f32x4 gc = wg0 * g2 + wg1 * g1 + wg2 * xg + bg, uc = wu0 * u2 + wu1 * u1 + wu2 * xu + bu;
                    f32x4 a;
#pragma unroll
                    for (int j = 0; j < 4; ++j) a[j] = gc[j] * pg8::fsigmoid(gc[j]) * uc[j];
                    if (m > 0 || fr >= 2) { u32x2v w; w.x = pg8::cvt_pk_bf16(a[0], a[1]); w.y = pg8::cvt_pk_bf16(a[2], a[3]); *(u32x2v*)(E.ACT + (size_t)row * DFFc + ch) = w; }
                    if (m == 0 && fr < 2) { float* h = E.HF + ((size_t)(blk * 2 + fr)) * NUPc; *(f32x4*)(h + ch) = xg; *(f32x4*)(h + DFFc + ch) = xu; }
                    if (m == 3 && fr >= 14) { float* h = E.HL + ((size_t)(blk * 2 + (fr - 14))) * NUPc; *(f32x4*)(h + ch) = xg; *(f32x4*)(h + DFFc + ch) = xu; }
                    q1g = p1g; q2g = p2g; q1u = p1u; q2u = p2u;
                }
            }
        }
    }
}
#ifndef REPW
#define REPW 1
#endif
#ifndef REPSCAN
#define REPSCAN 1
#endif
#ifndef REPHGRN
#define REPHGRN 1
#endif
#ifndef REPATTN
#define REPATTN 1
#endif
#ifndef REPUP
#define REPUP 1
#endif
#ifndef REPG1
#define REPG1 1
#endif
#ifndef REPA
#define REPA 1
#endif
#ifndef REPB
#define REPB 1
#endif
#ifndef REPC
#define REPC 1
#endif
#ifndef REPD
#define REPD 1
#endif
#ifndef REPSEL
#define REPSEL 1
#endif
#ifndef REPMERGE
#define REPMERGE 1
#endif
#ifndef REPLORA
#define REPLORA 1
#endif
#ifndef REPG1B
#define REPG1B 1
#endif
#ifndef XBAR
#define XBAR 0
#endif
#ifndef REPELT
#define REPELT 1
#endif
#ifndef MK_PER_PHASE
#define MK_PER_PHASE 0
#endif
constexpr int NPH = 14;
struct Args { const void* in[28]; float* out; unsigned char* ws; int ph_lo, ph_hi; };
__device__ __forceinline__ LayerIn make_layer(const Args& args, int layer) {
    LayerIn L;
    L.norm_mix = (const float*)args.in[2] + (size_t)layer * DM; L.w_in = (const float*)args.in[3] + (size_t)layer * DM * IN_COLS;
    L.lb0 = (const float*)args.in[4]; L.lb1 = (const float*)args.in[4] + 1024; L.out_norm = (const float*)args.in[5] + (size_t)layer * 128;
    L.mu = (const float*)args.in[6] + (size_t)layer * 3360; L.w0 = (const float*)args.in[7] + (size_t)layer * 1024; L.w2 = (const float*)args.in[8] + (size_t)layer * 64 * 1024;
    L.a0 = (const float*)args.in[9] + (size_t)layer * 1024; L.a2 = (const float*)args.in[10] + (size_t)layer * 64 * 1024; L.g2 = (const float*)args.in[11] + (size_t)layer * 160 * 1024;
    L.k_k = (const float*)args.in[12] + (size_t)layer * 1024; L.k_a = (const float*)args.in[13] + (size_t)layer * 1024; L.r_k = (const float*)args.in[14] + (size_t)layer * 1024;
    L.ln_w = (const float*)args.in[15] + (size_t)layer * 1024; L.ln_b = (const float*)args.in[16] + (size_t)layer * 1024;
    L.q_norm = (const float*)args.in[17] + (size_t)layer * 128; L.k_norm = (const float*)args.in[18] + (size_t)layer * 128;
    L.wba = (const float*)args.in[19] + (size_t)layer * 1024 * DM; L.wbb = (const float*)args.in[20] + (size_t)layer * 1024 * DM; L.wbc = (const float*)args.in[21] + (size_t)layer * 2048 * DM;
    L.w_out = (const float*)args.in[22] + (size_t)layer * DM * DM; L.norm_ffn = (const float*)args.in[23] + (size_t)layer * DM;
    L.w_up = (const float*)args.in[24] + (size_t)layer * DM * NUP; L.conv_w = (const float*)args.in[25] + (size_t)layer * 3 * NUP; L.conv_b = (const float*)args.in[26] + (size_t)layer * NUP;
    L.w_down = (const float*)args.in[27] + (size_t)layer * DFF * DM;
    return L;
}
__global__ void __launch_bounds__(NWAVES * 64, 2) mk_fwd(Args args) {
    extern __shared__ __attribute__((aligned(16))) unsigned char lds[];
    Frame F;
    F.lds = (LAS unsigned char*)lds;
    F.MISC = (volatile LAS unsigned*)(F.lds + MISC_OFF);
    F.tid = threadIdx.x; F.lane = F.tid & 63; F.wave = __builtin_amdgcn_readfirstlane(F.tid >> 6);
    F.G = gridDim.x; F.ws = args.ws; F.ctl = (gu32*)(args.ws + WS_CTL);
    for (int u = F.tid; u < (LDS_BYTES - LDSCTL_OFF) / 4; u += NWAVES * 64) ((LAS unsigned*)(F.lds + LDSCTL_OFF))[u] = 0u;
    __syncthreads();
    XcdBarrier bar; bar.bar = (unsigned*)(F.ctl + CW_BAR); bar.x = 0; bar.st = nullptr;
    if (!MK_PER_PHASE) bar = xcd_barrier_post((unsigned*)(F.ctl + CW_BAR), F.MISC + 8);
    const int lo = args.ph_lo, hi = args.ph_hi;
    float* xout = args.out;

    if (lo == 0) phase_rope_tables(F, (const int*)args.in[1]);
    for (int layer = 0; layer < 2; ++layer) {
        const float* xin = (layer == 0) ? (const float*)args.in[0] : (const float*)xout;
        const int pbase = layer * NPH;
#ifndef ONLY
#define ONLY -1
#endif
#define IN(k) ((ONLY < 0 || ONLY == (k)) && lo <= pbase + (k) && pbase + (k) < hi)
#define WSL() size_t wz_ = 0; asm volatile("" : "+s"(wz_)); unsigned char* wsb = args.ws + wz_; int bid = blockIdx.x; asm volatile("" : "+s"(bid)); int GG = F.G; asm volatile("" : "+s"(GG)); int wv = F.wave; asm volatile("" : "+s"(wv)); (void)bid; (void)GG; (void)wv; bf16* const XB = (bf16*)(wsb + WS_XB); const float* const RS0 = (const float*)(wsb + WS_RS); float* const SSQ = (float*)(wsb + WS_CTL + CTL_SSQ); (void)XB; (void)RS0; (void)SSQ
#define SEAM(k) do { if (!MK_PER_PHASE && (pbase + (k) + 2 < hi)) xcd_barrier(bar); } while (0)

        if (IN(0)) { WSL(); { const LayerIn L = make_layer(args, layer); for (int r_ = 0; r_ < REPW; ++r_) phase_weights(F, L); } if (layer == 0) phase_norm(F, xin); __syncthreads(); SEAM(0); }
        if (IN(1)) { WSL();
#if !defined(SUB) || SUB==1
            { pg8::Gemm g{XB, (const bf16*)(wsb + WS_WIN), M, NA1, DM}; pg8::StaticOrder S; S.init(M, NA1, GG, bid);
              pg8::EpiP1 E{(bf16*)(wsb + WS_PA), (float*)(wsb + WS_PAF), (bf16*)(wsb + WS_PB), (bf16*)(wsb + WS_PC), layer == 0 ? RS0 : SSQ + M};
              for (int r_ = 0; r_ < REPG1; ++r_) { pg8::gemm_phase<pg8::EpiP1, pg8::StaticOrder, true, true>(F.lds + RING_OFF, g, S, E, wv); __syncthreads(); } }
            __syncthreads();
#endif
        }
        if (IN(1)) { WSL();
#if !defined(SUB) || SUB==2
            { pg8::Gemm g{XB, (const bf16*)(wsb + WS_WIN) + (size_t)NA1 * DM, M, NGT, DM}; pg8::StaticOrder S; S.init(M, NGT, GG, bid);
              pg8::EpiB16<1> E{(bf16*)(wsb + WS_G), NGT, layer == 0 ? RS0 : SSQ + M};
              for (int r_ = 0; r_ < REPG1B; ++r_) { pg8::gemm_phase<pg8::EpiB16<1>, pg8::StaticOrder, true, true>(F.lds + RING_OFF, g, S, E, wv); __syncthreads(); } }
#endif
            __syncthreads(); SEAM(1);
        }
        if (IN(2)) { WSL(); { const LayerIn L = make_layer(args, layer); for (int r_ = 0; r_ < REPELT * REPB; ++r_) phase_prep(F, L); } SEAM(2); }
        if (IN(3)) { WSL();
#if !defined(SUB) || SUB==1
            { pg8::Gemm g{(const bf16*)(wsb + WS_LA), (const bf16*)(wsb + WS_WLORA), M, NLORA, KLORA}; pg8::StaticOrder S; S.init(M, NLORA, GG, bid);
              pg8::EpiB16Plain E{(bf16*)(wsb + WS_LO), NLORA};
              for (int r_ = 0; r_ < REPLORA; ++r_) { pg8::gemm_phase<pg8::EpiB16Plain, pg8::StaticOrder, true, true>(F.lds + RING_OFF, g, S, E, wv); __syncthreads(); } }
#endif
            __syncthreads();
#if !defined(SUB) || SUB==2
            for (int r_ = 0; r_ < REPELT * REPC; ++r_) phase_indexer(F);
#endif
            SEAM(3);
        }
        if (IN(4)) { WSL(); { const LayerIn L = make_layer(args, layer); for (int r_ = 0; r_ < REPELT * REPA; ++r_) phase_bprep2(F, L); } for (int r_ = 0; r_ < REPELT * REPC * REPSEL; ++r_) phase_select(F); SEAM(4); }
        if (IN(5)) { WSL(); __syncthreads();
#if !defined(SUB) || SUB==1 || SUB==2
            { const LayerIn L = make_layer(args, layer);
#ifndef DO_SCAN
#define DO_SCAN 1
#endif
#ifndef DO_HGRN
#define DO_HGRN 1
#endif
              for (int r_ = 0; r_ < (REPSCAN > REPHGRN ? REPSCAN : REPHGRN); ++r_) phase_scan_hgrn(F, L, layer, DO_SCAN && r_ < REPSCAN, DO_HGRN && r_ < REPHGRN);
            }
#endif
#if !defined(SUB) || SUB==3
            { const LayerIn L = make_layer(args, layer); phase_attn(F, layer, L.q_norm, L.k_norm);
#if REPATTN > 1
            phase_attn(F, layer + 2, L.q_norm, L.k_norm);
#endif
            }
#endif
            SEAM(5); }
        for (int xb_ = 0; xb_ < XBAR; ++xb_) xcd_barrier(bar);
        if (IN(6)) { WSL(); { const LayerIn L = make_layer(args, layer); for (int r_ = 0; r_ < REPELT * REPA; ++r_) phase_post(F, L); } SEAM(6); }
        if (IN(7)) { WSL();
          for (int rm_ = 0; rm_ < REPMERGE; ++rm_) {
            __syncthreads();
            { pg8::Gemm g{(const bf16*)(wsb + WS_OA), (const bf16*)(wsb + WS_WA), M, DM, 2048};
              pg8::MergeOrder S; S.init(M, DM, GG, bid);
              static_assert(WS_OB - WS_OA == WS_OC - WS_OB && WS_WB - WS_WA == WS_WC - WS_WB, "merge operands at equal spacing");
              S.A0 = (const bf16*)(wsb + WS_OA); S.sA = (WS_OB - WS_OA) / 2; S.B0 = (const bf16*)(wsb + WS_WA); S.sB = (WS_WB - WS_WA) / 2;
              pg8::EpiMerge3 E{(bf16*)(wsb + WS_MERGED), (const bf16*)(wsb + WS_G)};
              pg8::gemm_phase<pg8::EpiMerge3, pg8::MergeOrder, true, true>(F.lds + RING_OFF, g, S, E, wv); }
            __syncthreads();
          }
            SEAM(7);
        }
        if (IN(8)) { WSL();
            __syncthreads();
            { pg8::Gemm g{(const bf16*)(wsb + WS_MERGED), (const bf16*)(wsb + WS_WOUT), M, DM, DM}; pg8::StaticOrder S; S.init(M, DM, GG, bid);
              pg8::EpiRes E{xin, xout, DM, XB, SSQ + (layer == 0 ? 0 : 2 * M)};
              pg8::gemm_phase<pg8::EpiRes, pg8::StaticOrder, true, true>(F.lds + RING_OFF, g, S, E, wv); }
            __syncthreads(); SEAM(8);
        }
        if (IN(10)) { WSL();
            __syncthreads();
            { const LayerIn L = make_layer(args, layer);
              pg8::Gemm g{XB, (const bf16*)(wsb + WS_WUP), M, NUP, DM}; pg8::SplitTailOrder S; S.init(M, NUP, GG, bid);
              typedef pg8::EpiTail<pg8::EpiConvAct, (long)(WS_ACT - WS_PART)> EpiUp;
              EpiUp E{{(bf16*)(wsb + WS_ACT), SSQ + (layer == 0 ? 0 : 2 * M), L.conv_w, L.conv_b, (float*)(wsb + WS_HALOF), (float*)(wsb + WS_HALOL)}};
              for (int r_ = 0; r_ < REPUP; ++r_) { pg8::gemm_phase<EpiUp, pg8::SplitTailOrder, true, true>(F.lds + RING_OFF, g, S, E, wv); __syncthreads(); } }
            __syncthreads(); SEAM(10);
        }
        if (IN(11)) { WSL();
            { const LayerIn L = make_layer(args, layer);
              pg8::SplitTailOrder S; S.init(M, NUP, GG, bid);
              const pg8::EpiConvAct E{(bf16*)(wsb + WS_ACT), SSQ + (layer == 0 ? 0 : 2 * M), L.conv_w, L.conv_b, (float*)(wsb + WS_HALOF), (float*)(wsb + WS_HALOL)};
              phase_tailfix(F, E, S, (const float*)(wsb + WS_PART)); }
            __syncthreads(); if (!MK_PER_PHASE) xcd_barrier(bar);
            { const LayerIn L = make_layer(args, layer); for (int r_ = 0; r_ < REPELT * REPD; ++r_) phase_convfix(F, L); } SEAM(11); }
        if (IN(12)) { WSL();
            __syncthreads();
            { pg8::Gemm g{(const bf16*)(wsb + WS_ACT), (const bf16*)(wsb + WS_WDN), M, DM, DFF}; pg8::StaticOrder S; S.init(M, DM, GG, bid);
              pg8::EpiRes E{xout, xout, DM, layer == 0 ? XB : nullptr, layer == 0 ? SSQ + M : nullptr};
              pg8::gemm_phase<pg8::EpiRes, pg8::StaticOrder, true, true>(F.lds + RING_OFF, g, S, E, wv); }
            __syncthreads(); SEAM(12);
        }
#undef IN
#undef SEAM
    }
}

extern "C" void kernel_launch(void* const* d_in, const int* in_sizes, int n_in, void* d_out, int out_size, void* d_ws, size_t ws_size, hipStream_t stream) {
    static int grid = 0;
    if (grid == 0) {
        if (n_in != 28 || out_size != M * DM || ws_size < WS_END) { fprintf(stderr, "kernel_launch: unexpected problem (n_in %d, out %d, ws %zu < %zu); nothing launched\n", n_in, out_size, ws_size, (size_t)WS_END); grid = -1; return; }
        int dev = 0, cus = 0, per_cu = 0;
        if (hipGetDevice(&dev) != hipSuccess || hipDeviceGetAttribute(&cus, hipDeviceAttributeMultiprocessorCount, dev) != hipSuccess) { grid = -1; return; }
        if (hipFuncSetAttribute((const void*)mk_fwd, hipFuncAttributeMaxDynamicSharedMemorySize, LDS_BYTES) != hipSuccess) { fprintf(stderr, "kernel_launch: hipFuncSetAttribute failed\n"); grid = -1; return; }
        if (hipOccupancyMaxActiveBlocksPerMultiprocessor(&per_cu, (const void*)mk_fwd, NWAVES * 64, LDS_BYTES) != hipSuccess || per_cu < 1)
            fprintf(stderr, "kernel_launch: note: occupancy query reports %d workgroups per CU\n", per_cu);
        (void)hipGetLastError();
        grid = cus;
    }
    if (grid < 0) return;
    if (hipMemsetAsync((char*)d_ws + WS_CTL, 0, CTL_ZERO_BYTES, stream) != hipSuccess) { fprintf(stderr, "kernel_launch: memset failed\n"); return; }
    Args a{};
    for (int i = 0; i < 28; ++i) a.in[i] = d_in[i];
    a.out = (float*)d_out; a.ws = (unsigned char*)d_ws;
#if MK_PER_PHASE
    for (int p = 0; p < 2 * NPH; ++p) { if (p % NPH == 13) continue; a.ph_lo = p; a.ph_hi = p + 1; hipLaunchKernelGGL(mk_fwd, dim3(grid), dim3(NWAVES * 64), LDS_BYTES, stream, a); }
#else
    a.ph_lo = 0; a.ph_hi = 2 * NPH;
    hipLaunchKernelGGL(mk_fwd, dim3(grid), dim3(NWAVES * 64), LDS_BYTES, stream, a);
#endif
    const hipError_t le = hipPeekAtLastError();
    if (le != hipSuccess) fprintf(stderr, "kernel_launch: launch failed: %s\n", hipGetErrorName(le));
}
```
